# Optimizing an MI355X kernel written in HIP

```python
import jax, jax.numpy as jnp
from jax import lax
import numpy as np

D_MODEL = 1024
BATCH = 32
SEQ = 256
DEPTH = 4
DEC_BATCH = 4
DEC_SEQ = 4096
PAST_LEN = 256

GRID_W = 64
N_EVEN = (DEPTH + 1) // 2
N_ODD = DEPTH // 2
EPS = 1e-6
NEG_INF = -1e30
A_HEADS = 8
A_KV_HEADS = 2
GQA_GROUP = A_HEADS // A_KV_HEADS
HEAD_DIM = 64
WINDOW = 128
BLOCK = 128
ROPE_BASE = 10000.0
B_HEADS = 4
B_DK = 64
B_DV = 128
GATE_RANK = 16
GATE_NORMALIZER = 16.0
GLA_CHUNK = 16
D_RNN = D_MODEL
RG_BLOCKS = 16
RG_BW = D_RNN // RG_BLOCKS
RG_C = 8.0
CONV_W = 4
D_FF = 2816
FFN_CONV_W = 3
A_Q = A_HEADS * HEAD_DIM
A_KV = A_KV_HEADS * HEAD_DIM
B_QK = B_HEADS * B_DK
B_V = B_HEADS * B_DV
EVEN_IN = A_Q + 2 * A_KV + 2 * B_QK + 2 * B_V + 2 * GATE_RANK
MIX_OUT = A_Q + B_V

kernel_name = 'hybrid_swa_gla_rglru_prefix_diffusion_step'


def _rmsnorm(x, g):
    xf = x.astype(jnp.float32)
    y = xf * lax.rsqrt(jnp.mean(xf * xf, axis=-1, keepdims=True) + EPS)
    return (y * g.astype(jnp.float32)).astype(x.dtype)


def _modulation(cond, w_ada, b_ada):
    m = jax.nn.silu(cond) @ w_ada + b_ada
    return jnp.split(m[:, None, :], 6, axis=-1)


def _modulate(x, g, shift, scale):
    return _rmsnorm(x, g) * (1.0 + scale) + shift


def _dwconv(x, w, b):
    width = w.shape[0]
    left = width // 2
    t_len = x.shape[1]
    xp = jnp.pad(x, ((0, 0), (left, width - 1 - left), (0, 0)))
    out = xp[:, 0:t_len] * w[0]
    for k in range(1, width):
        out = out + xp[:, k:k + t_len] * w[k]
    return out + b


def _axial_rope_tables(t_len, dtype):
    rows = t_len // GRID_W
    row = jnp.repeat(jnp.arange(rows, dtype=jnp.float32), GRID_W)
    col = jnp.tile(jnp.arange(GRID_W, dtype=jnp.float32), rows)
    n_freq = HEAD_DIM // 4
    inv_freq = jnp.power(ROPE_BASE, -jnp.arange(n_freq, dtype=jnp.float32) / n_freq)
    ang_r = row[:, None, None] * inv_freq
    ang_c = col[:, None, None] * inv_freq
    return (jnp.cos(ang_r).astype(dtype), jnp.sin(ang_r).astype(dtype),
            jnp.cos(ang_c).astype(dtype), jnp.sin(ang_c).astype(dtype))


def _rot_half(t, cos, sin):
    n = t.shape[-1] // 2
    t1, t2 = t[..., :n], t[..., n:]
    return jnp.concatenate([t1 * cos - t2 * sin, t1 * sin + t2 * cos], axis=-1)


def _axial_rope(x, cos_r, sin_r, cos_c, sin_c):
    half = HEAD_DIM // 2
    return jnp.concatenate([_rot_half(x[..., :half], cos_r, sin_r),
                            _rot_half(x[..., half:], cos_c, sin_c)], axis=-1)


def _attn_context(q, k, v, sink):
    bsz, s_len = q.shape[0], q.shape[1]
    nq = s_len // BLOCK
    qb = (q * HEAD_DIM ** -0.5).reshape(bsz, nq, BLOCK, A_KV_HEADS, GQA_GROUP, HEAD_DIM).transpose(1, 0, 2, 3, 4, 5)
    sink_l = sink.astype(jnp.float32).reshape(A_KV_HEADS, GQA_GROUP)[None, :, :, None, None]

    def one_block(qblk):
        s = jnp.einsum('bqkgd,bskd->bkgqs', qblk, k, preferred_element_type=jnp.float32)
        logits = jnp.concatenate([s, jnp.broadcast_to(sink_l, s.shape[:-1] + (1,))], axis=-1)
        p = jax.nn.softmax(logits, axis=-1)[..., :-1].astype(v.dtype)
        return jnp.einsum('bkgqs,bskd->bqkgd', p, v)

    o = lax.map(one_block, qb)
    return o.transpose(1, 0, 2, 3, 4, 5).reshape(bsz, s_len, A_Q)


def _attn_latent(q, k, v, k_ctx, v_ctx, sink):
    bsz, t_len = q.shape[0], q.shape[1]
    nb = t_len // BLOCK
    qb = (q * HEAD_DIM ** -0.5).reshape(bsz, nb, BLOCK, A_KV_HEADS, GQA_GROUP, HEAD_DIM).transpose(1, 0, 2, 3, 4, 5)

    def neighbours(t):
        tb = jnp.pad(t, ((0, 0), (BLOCK, BLOCK), (0, 0), (0, 0))).reshape(bsz, nb + 2, BLOCK, A_KV_HEADS, HEAD_DIM)
        win = jnp.concatenate([tb[:, :-2], tb[:, 1:-1], tb[:, 2:]], axis=2)
        return win.transpose(1, 0, 2, 3, 4)

    kw, vw = neighbours(k), neighbours(v)
    qi = jnp.arange(BLOCK)[:, None]
    kj = jnp.arange(3 * BLOCK)[None, :]
    rel = kj - BLOCK - qi
    kpos = (jnp.arange(nb)[:, None, None] - 1) * BLOCK + kj[None]
    valid = (jnp.abs(rel) <= WINDOW)[None] & (kpos >= 0) & (kpos < t_len)
    sink_l = sink.astype(jnp.float32).reshape(A_KV_HEADS, GQA_GROUP)[None, :, :, None, None]

    def one_block(args):
        qblk, kblk, vblk, ok = args
        s_w = jnp.einsum('bqkgd,bskd->bkgqs', qblk, kblk, preferred_element_type=jnp.float32)
        s_w = jnp.where(ok[None, None, None], s_w, NEG_INF)
        s_c = jnp.einsum('bqkgd,bpkd->bkgqp', qblk, k_ctx, preferred_element_type=jnp.float32)
        snk = jnp.broadcast_to(sink_l, s_w.shape[:-1] + (1,))
        p = jax.nn.softmax(jnp.concatenate([s_w, s_c, snk], axis=-1), axis=-1).astype(v.dtype)
        return (jnp.einsum('bkgqs,bskd->bqkgd', p[..., :3 * BLOCK], vblk)
                + jnp.einsum('bkgqp,bpkd->bqkgd', p[..., 3 * BLOCK:-1], v_ctx))

    o = lax.map(one_block, (qb, kw, vw, valid))
    return o.transpose(1, 0, 2, 3, 4, 5).reshape(bsz, t_len, A_Q)


def _gla_chunked(q, k, v, log_a, s0):
    bsz, t_len, nh, dk = q.shape
    dv = v.shape[-1]
    n = t_len // GLA_CHUNK

    def chunks(t):
        return t.reshape(bsz, n, GLA_CHUNK, nh, t.shape[-1]).transpose(1, 0, 3, 2, 4).astype(jnp.float32)

    qc, kc, vc, lc = chunks(q), chunks(k), chunks(v), chunks(log_a)
    b = jnp.cumsum(lc, axis=3)
    causal = jnp.tril(jnp.ones((GLA_CHUNK, GLA_CHUNK), dtype=bool))[:, :, None]
    rel = b[..., :, None, :] - b[..., None, :, :]
    decay = jnp.exp(jnp.where(causal, rel, NEG_INF))
    scores = jnp.einsum('nbhid,nbhijd,nbhjd->nbhij', qc, decay, kc)
    o_intra = jnp.einsum('nbhij,nbhjv->nbhiv', scores, vc)
    b_last = b[..., -1:, :]
    q_in = qc * jnp.exp(b)
    k_in = kc * jnp.exp(b_last - b)
    a_chunk = jnp.exp(b_last[..., 0, :])

    def step(s, xs):
        qi, ki, vi, ai = xs
        o = jnp.einsum('bhcd,bhdv->bhcv', qi, s)
        s = ai[..., None] * s + jnp.einsum('bhcd,bhcv->bhdv', ki, vi)
        return s, o

    s_fin, o_inter = lax.scan(step, s0.astype(jnp.float32), (q_in, k_in, vc, a_chunk))
    o = (o_intra + o_inter).transpose(1, 0, 3, 2, 4).reshape(bsz, t_len, nh, dv)
    return o.astype(v.dtype), s_fin.astype(v.dtype)


def _gla_bidir(q, k, v, la_f, la_b, s0_f, s0_b):
    o_f, s_f = _gla_chunked(q, k, v, la_f, s0_f)
    o_b, s_b = _gla_chunked(q[:, ::-1], k[:, ::-1], v[:, ::-1], la_b[:, ::-1], s0_b)
    return o_f + o_b[:, ::-1], s_f, s_b


def _even_project(h, w_in, w_gate_f, b_gate_f, w_gate_b, b_gate_b):
    bsz, t_len = h.shape[0], h.shape[1]
    sizes = (A_Q, A_KV, A_KV, B_QK, B_QK, B_V, B_V, GATE_RANK, GATE_RANK)
    cuts = [sum(sizes[:n]) for n in range(1, len(sizes))]
    q_a, k_a, v_a, q_b, k_b, v_b, g_b, r_f, r_b = jnp.split(h @ w_in, cuts, axis=-1)
    q_a = q_a.reshape(bsz, t_len, A_HEADS, HEAD_DIM)
    k_a = k_a.reshape(bsz, t_len, A_KV_HEADS, HEAD_DIM)
    v_a = v_a.reshape(bsz, t_len, A_KV_HEADS, HEAD_DIM)
    q_b = q_b.reshape(bsz, t_len, B_HEADS, B_DK) * (B_DK ** -0.5)
    k_b = k_b.reshape(bsz, t_len, B_HEADS, B_DK)
    v_b = v_b.reshape(bsz, t_len, B_HEADS, B_DV)
    la_f = jax.nn.log_sigmoid((r_f @ w_gate_f + b_gate_f).astype(jnp.float32)).reshape(bsz, t_len, B_HEADS, B_DK) / GATE_NORMALIZER
    la_b = jax.nn.log_sigmoid((r_b @ w_gate_b + b_gate_b).astype(jnp.float32)).reshape(bsz, t_len, B_HEADS, B_DK) / GATE_NORMALIZER
    return q_a, k_a, v_a, q_b, k_b, v_b, g_b, la_f, la_b


def _even_output(o_a, o_b, g_b, gla_norm, w_out):
    bsz, t_len = o_a.shape[0], o_a.shape[1]
    o_b = _rmsnorm(o_b, gla_norm).reshape(bsz, t_len, B_V) * jax.nn.silu(g_b)
    return jnp.concatenate([o_a, o_b], axis=-1) @ w_out


def _even_context(h, w_in, sink, w_gate_f, b_gate_f, w_gate_b, b_gate_b, gla_norm, w_out):
    q_a, k_a, v_a, q_b, k_b, v_b, g_b, la_f, la_b = _even_project(h, w_in, w_gate_f, b_gate_f, w_gate_b, b_gate_b)
    o_a = _attn_context(q_a, k_a, v_a, sink)
    s0 = jnp.zeros((h.shape[0], B_HEADS, B_DK, B_DV), jnp.float32)
    o_b, s_f, s_b = _gla_bidir(q_b, k_b, v_b, la_f, la_b, s0, s0)
    return _even_output(o_a, o_b, g_b, gla_norm, w_out), k_a, v_a, s_f, s_b


def _even_latent(h, k_ctx, v_ctx, s0_f, s0_b, rope, w_in, sink, w_gate_f, b_gate_f, w_gate_b, b_gate_b, gla_norm, w_out):
    q_a, k_a, v_a, q_b, k_b, v_b, g_b, la_f, la_b = _even_project(h, w_in, w_gate_f, b_gate_f, w_gate_b, b_gate_b)
    q_a = _axial_rope(q_a, rope[0], rope[1], rope[2], rope[3])
    k_a = _axial_rope(k_a, rope[0], rope[1], rope[2], rope[3])
    o_a = _attn_latent(q_a, k_a, v_a, k_ctx, v_ctx, sink)
    o_b, _, _ = _gla_bidir(q_b, k_b, v_b, la_f, la_b, s0_f, s0_b)
    return _even_output(o_a, o_b, g_b, gla_norm, w_out)


def _block_diag(x, w, b):
    xb = x.reshape(x.shape[:-1] + (RG_BLOCKS, RG_BW))
    return jnp.einsum('btnd,nde->btne', xb, w).reshape(x.shape) + b


def _combine(left, right):
    a_l, u_l = left
    a_r, u_r = right
    return a_l * a_r, a_r * u_l + u_r


def _rglru(x, w_a, b_a, w_i, b_i, lam, h0):
    xf = x.astype(jnp.float32)
    r = jax.nn.sigmoid(_block_diag(xf, w_a, b_a))
    i = jax.nn.sigmoid(_block_diag(xf, w_i, b_i))
    log_a = RG_C * r * jax.nn.log_sigmoid(lam.astype(jnp.float32))
    a = jnp.exp(log_a)
    u = jnp.sqrt(-jnp.expm1(2.0 * log_a)) * (i * xf)
    a_cum, u_cum = lax.associative_scan(_combine, (a, u), axis=1)
    h = a_cum * h0.astype(jnp.float32)[:, None, :] + u_cum
    return h.astype(x.dtype)


def _odd_mixer(h, h0_f, h0_b, w_in, conv_w, conv_b, w_a, b_a, w_i, b_i, lam, w_out):
    y, xr = jnp.split(h @ w_in, 2, axis=-1)
    xr = _dwconv(xr, conv_w, conv_b)
    h_f = _rglru(xr, w_a[0], b_a[0], w_i[0], b_i[0], lam[0], h0_f)
    h_b = _rglru(xr[:, ::-1], w_a[1], b_a[1], w_i[1], b_i[1], lam[1], h0_b)[:, ::-1]
    out = (jax.nn.gelu(y) * (h_f + h_b)) @ w_out
    return out, h_f[:, -1], h_b[:, 0]


def _conv_ffn(h, w_up, conv_w, conv_b, w_down):
    u = _dwconv(h @ w_up, conv_w, conv_b)
    gate, val = jnp.split(u, 2, axis=-1)
    return (jax.nn.silu(gate) * val) @ w_down


def setup_inputs(seed: int = 0) -> dict:
    key = jax.random.key(seed)
    ks = jax.random.split(key, 48)
    f32 = jnp.float32

    def nrm(i, shape, scale):
        return jax.random.normal(ks[i], shape, f32) * scale

    u = jax.random.uniform(ks[40], (N_ODD, 2, D_RNN), f32, 0.9, 0.999)
    s = u ** (1.0 / RG_C)
    lam = jnp.log(s) - jnp.log1p(-s)
    return {
        'x_prompt': nrm(0, (BATCH, SEQ, D_MODEL), 1.0),
        'x_sample': nrm(1, (DEC_BATCH, DEC_SEQ, D_MODEL), 1.0),
        'cache_attn_k': nrm(2, (DEC_BATCH, N_EVEN, PAST_LEN, A_KV_HEADS, HEAD_DIM), 1.0),
        'cache_attn_v': nrm(3, (DEC_BATCH, N_EVEN, PAST_LEN, A_KV_HEADS, HEAD_DIM), 1.0),
        'state_gla': nrm(4, (DEC_BATCH, N_EVEN, 2, B_HEADS, B_DK, B_DV), 1.0),
        'state_rglru': nrm(5, (DEC_BATCH, N_ODD, 2, D_RNN), 0.5),
        'c': nrm(6, (DEC_BATCH, D_MODEL), 1.0),
        'c_ctx': nrm(7, (D_MODEL,), 1.0),
        'norm_mix': 1.0 + nrm(8, (DEPTH, D_MODEL), 0.02),
        'norm_ffn': 1.0 + nrm(9, (DEPTH, D_MODEL), 0.02),
        'w_ada': nrm(10, (DEPTH, D_MODEL, 6 * D_MODEL), 0.2 * D_MODEL ** -0.5),
        'b_ada': nrm(11, (DEPTH, 6 * D_MODEL), 0.01),
        'ev_w_in': nrm(12, (N_EVEN, D_MODEL, EVEN_IN), D_MODEL ** -0.5),
        'ev_sink': nrm(13, (N_EVEN, A_HEADS), 1.0),
        'ev_w_gate_f': nrm(14, (N_EVEN, GATE_RANK, B_QK), GATE_RANK ** -0.5),
        'ev_b_gate_f': nrm(15, (N_EVEN, B_QK), 0.1),
        'ev_w_gate_b': nrm(16, (N_EVEN, GATE_RANK, B_QK), GATE_RANK ** -0.5),
        'ev_b_gate_b': nrm(17, (N_EVEN, B_QK), 0.1),
        'ev_gla_norm': 1.0 + nrm(18, (N_EVEN, B_DV), 0.02),
        'ev_w_out': nrm(19, (N_EVEN, MIX_OUT, D_MODEL), MIX_OUT ** -0.5),
        'od_w_in': nrm(20, (N_ODD, D_MODEL, 2 * D_RNN), D_MODEL ** -0.5),
        'od_conv_w': nrm(21, (N_ODD, CONV_W, D_RNN), CONV_W ** -0.5),
        'od_conv_b': nrm(22, (N_ODD, D_RNN), 0.01),
        'od_w_a': nrm(23, (N_ODD, 2, RG_BLOCKS, RG_BW, RG_BW), RG_BW ** -0.5),
        'od_b_a': nrm(24, (N_ODD, 2, D_RNN), 0.01),
        'od_w_i': nrm(25, (N_ODD, 2, RG_BLOCKS, RG_BW, RG_BW), RG_BW ** -0.5),
        'od_b_i': nrm(26, (N_ODD, 2, D_RNN), 0.01),
        'od_lambda': lam,
        'od_w_out': nrm(27, (N_ODD, D_RNN, D_MODEL), D_RNN ** -0.5),
        'ffn_w_up': nrm(28, (DEPTH, D_MODEL, 2 * D_FF), D_MODEL ** -0.5),
        'ffn_conv_w': nrm(29, (DEPTH, FFN_CONV_W, 2 * D_FF), FFN_CONV_W ** -0.5),
        'ffn_conv_b': nrm(30, (DEPTH, 2 * D_FF), 0.01),
        'ffn_w_down': nrm(31, (DEPTH, D_FF, D_MODEL), D_FF ** -0.5),
        'final_norm': 1.0 + nrm(32, (D_MODEL,), 0.02),
    }


def reference(x_prompt, x_sample, cache_attn_k, cache_attn_v, state_gla, state_rglru, c, c_ctx,
              norm_mix, norm_ffn, w_ada, b_ada,
              ev_w_in, ev_sink, ev_w_gate_f, ev_b_gate_f, ev_w_gate_b, ev_b_gate_b, ev_gla_norm, ev_w_out,
              od_w_in, od_conv_w, od_conv_b, od_w_a, od_b_a, od_w_i, od_b_i, od_lambda, od_w_out,
              ffn_w_up, ffn_conv_w, ffn_conv_b, ffn_w_down, final_norm):
    rope = _axial_rope_tables(x_sample.shape[1], x_sample.dtype)
    xp, xs = x_prompt, x_sample
    new_k, new_v, new_gla, new_rg = [], [], [], []
    for layer in range(DEPTH):
        j = layer // 2
        sh_mp, sc_mp, g_mp, sh_fp, sc_fp, g_fp = _modulation(c_ctx[None, :], w_ada[layer], b_ada[layer])
        sh_ms, sc_ms, g_ms, sh_fs, sc_fs, g_fs = _modulation(c, w_ada[layer], b_ada[layer])
        hp = _modulate(xp, norm_mix[layer], sh_mp, sc_mp)
        hs = _modulate(xs, norm_mix[layer], sh_ms, sc_ms)
        if layer % 2 == 0:
            ew = (ev_w_in[j], ev_sink[j], ev_w_gate_f[j], ev_b_gate_f[j], ev_w_gate_b[j], ev_b_gate_b[j],
                  ev_gla_norm[j], ev_w_out[j])
            out_p, k_c, v_c, s_f, s_b = _even_context(hp, *ew)
            out_s = _even_latent(hs, cache_attn_k[:, j], cache_attn_v[:, j], state_gla[:, j, 0], state_gla[:, j, 1],
                                 rope, *ew)
            new_k.append(k_c)
            new_v.append(v_c)
            new_gla.append(jnp.stack([s_f, s_b], axis=1))
        else:
            ow = (od_w_in[j], od_conv_w[j], od_conv_b[j], od_w_a[j], od_b_a[j], od_w_i[j], od_b_i[j],
                  od_lambda[j], od_w_out[j])
            h0 = jnp.zeros((xp.shape[0], D_RNN), xp.dtype)
            out_p, r_f, r_b = _odd_mixer(hp, h0, h0, *ow)
            out_s, _, _ = _odd_mixer(hs, state_rglru[:, j, 0], state_rglru[:, j, 1], *ow)
            new_rg.append(jnp.stack([r_f, r_b], axis=1))
        xp = xp + g_mp * out_p
        xs = xs + g_ms * out_s
        hp = _modulate(xp, norm_ffn[layer], sh_fp, sc_fp)
        hs = _modulate(xs, norm_ffn[layer], sh_fs, sc_fs)
        xp = xp + g_fp * _conv_ffn(hp, ffn_w_up[layer], ffn_conv_w[layer], ffn_conv_b[layer], ffn_w_down[layer])
        xs = xs + g_fs * _conv_ffn(hs, ffn_w_up[layer], ffn_conv_w[layer], ffn_conv_b[layer], ffn_w_down[layer])
    y_prompt = _rmsnorm(xp, final_norm)
    y_sample = _rmsnorm(xs, final_norm)
    new_attn_k = jnp.stack(new_k, axis=1)
    new_attn_v = jnp.stack(new_v, axis=1)
    new_state_gla = jnp.stack(new_gla, axis=1)
    new_state_rglru = jnp.stack(new_rg, axis=1)
    return (y_prompt, y_sample, new_attn_k, new_attn_v, new_state_gla, new_state_rglru)
```

```cpp
#include <hip/hip_runtime.h>
#include <hip/hip_cooperative_groups.h>
#include <cstdio>
#include <cstdint>
#include <cstring>
namespace cg = cooperative_groups;

#ifndef COOP
#define COOP 1
#endif
#ifndef PROBE_GEMM2
#define PROBE_GEMM2 0
#endif
#ifndef PROBE
#define PROBE 0
#endif
#define PB(b) ((PROBE >> (b)) & 1)
#ifndef ONLYP
#define ONLYP -1
#endif
#define EN(x) (ONLYP < 0 || ONLYP == (x))

typedef unsigned short bf16_t;
#define LAS __attribute__((address_space(3)))
using bf16x8 = __attribute__((ext_vector_type(8))) short;
using f32x4 = __attribute__((ext_vector_type(4))) float;

#define T_ALL 24576
#define T_PROMPT 8192
#define DM 1024
#define EV_IN 2336
#define EV_INP 2432
#define DFF 2816
#define DFF2 5632
#define NPH 42
#define LDS_BYTES 77840
#define LOG2E 1.4426950408889634f

#define OUT_K 25165824
#define OUT_V 27262976
#define OUT_GLA 29360128
#define OUT_RG 33554432

#define WS_MOD 4096ull
#define WS_ROPE (WS_MOD + 491520ull)
#define WS_RGAGG (WS_ROPE + 8192ull)
#define WS_GLA_A (WS_RGAGG + 6291456ull)
#define WS_WB (WS_GLA_A + 786432ull)
#define WS_H (WS_WB + 24903680ull)
#define WS_REGION (WS_H + 50331648ull)
#define WS_STATES (WS_REGION + 138412032ull)
#define WS_BAR (WS_STATES + 100663296ull)
#define WS_QCTR (WS_BAR + 16384ull)
#define WS_RGC (WS_QCTR + 32768ull)
#define WS_CARRY (WS_RGC + 8192ull)
#define WS_END (WS_CARRY + 3145728ull)

#define WB_IN 0
#define WB_OUT 2490368
#define WB_UP (WB_OUT + 1048576)
#define WB_DOWN (WB_UP + 5767168)
#define WB_RG (WB_DOWN + 2883584)

struct P {
  const float* in[34];
  float* out;
  unsigned char* ws;
  int ph_lo, ph_hi, coop, pad;
};

__device__ __forceinline__ int TID() { int t = threadIdx.x; asm volatile("" : "+v"(t)); return t; }
__device__ __forceinline__ int BID() { int b = blockIdx.x; asm volatile("" : "+s"(b)); return b; }
typedef __bf16 bf16x2_t __attribute__((ext_vector_type(2)));
typedef float f32x2_t __attribute__((ext_vector_type(2)));
__device__ __forceinline__ unsigned int pack2(float a, float b) { f32x2_t v = {a, b}; bf16x2_t r = __builtin_convertvector(v, bf16x2_t); return __builtin_bit_cast(unsigned int, r); }
__device__ __forceinline__ unsigned short f2bf(float f) { return (unsigned short)(pack2(f, 0.f) & 0xffffu); }
__device__ __forceinline__ float bf2f(unsigned short h) { return __uint_as_float(((unsigned int)h) << 16); }
__device__ __forceinline__ float bflo(unsigned int u) { return __uint_as_float(u << 16); }
__device__ __forceinline__ float bfhi(unsigned int u) { return __uint_as_float(u & 0xffff0000u); }
__device__ __forceinline__ void unpack8(uint4 r, float* x) {
  x[0] = bflo(r.x); x[1] = bfhi(r.x); x[2] = bflo(r.y); x[3] = bfhi(r.y);
  x[4] = bflo(r.z); x[5] = bfhi(r.z); x[6] = bflo(r.w); x[7] = bfhi(r.w);
}
__device__ __forceinline__ uint4 pack8(const float* x) {
  uint4 r; r.x = pack2(x[0], x[1]); r.y = pack2(x[2], x[3]); r.z = pack2(x[4], x[5]); r.w = pack2(x[6], x[7]); return r;
}
__device__ __forceinline__ float wave_sum(float v) {
#pragma unroll
  for (int o = 1; o < 64; o <<= 1) v += __shfl_xor(v, o);
  return v;
}
__device__ __forceinline__ float sigmoidf_(float x) { return 1.f / (1.f + expf(-x)); }
__device__ __forceinline__ float siluf_(float x) { return x / (1.f + expf(-x)); }
__device__ __forceinline__ float logsigf_(float z) { return fminf(z, 0.f) - log1pf(expf(-fabsf(z))); }
__device__ __forceinline__ float frcp(float x) { return __builtin_amdgcn_rcpf(x); }
__device__ __forceinline__ float fsigmoid(float x) { return frcp(1.f + __expf(-x)); }
__device__ __forceinline__ float fsilu(float x) { return x * fsigmoid(x); }
__device__ __forceinline__ float flogsig(float z) { return fminf(z, 0.f) - 0.6931471806f * __builtin_amdgcn_logf(1.f + __builtin_amdgcn_exp2f(-fabsf(z) * LOG2E)); }
__device__ __forceinline__ float gelu_tanh(float x) {
  const float z2 = 1.5957691216057308f * (x + 0.044715f * x * x * x);
  return x * __builtin_amdgcn_rcpf(1.f + __builtin_amdgcn_exp2f(-z2 * LOG2E));
}
__device__ __forceinline__ int tok_cond(int t) { return t < T_PROMPT ? 0 : 1 + ((t - T_PROMPT) >> 12); }
__device__ __forceinline__ void tok_seq(int t, int& s0, int& len) {
  if (t < T_PROMPT) { s0 = t & ~255; len = 256; } else { s0 = T_PROMPT + (((t - T_PROMPT) >> 12) << 12); len = 4096; }
}
__device__ __forceinline__ f32x4 mfma16(bf16x8 a, bf16x8 b, f32x4 c) { return __builtin_amdgcn_mfma_f32_16x16x32_bf16(a, b, c, 0, 0, 0); }
__device__ __forceinline__ bf16x8 frag(const bf16_t* s, int row0, int ks, int lane) {
  return *(const bf16x8*)(s + (row0 + (lane & 15)) * 72 + ks * 32 + (lane >> 4) * 8);
}

__device__ __forceinline__ bf16x8 frag_sw(const bf16_t* s, int row0, int ks, int lane) {
  const int kc = (ks * 4 + (lane >> 4)) ^ ((lane >> 1) & 7);
  return *(const bf16x8*)(s + (row0 + (lane & 15)) * 64 + kc * 8);
}

__device__ __forceinline__ void phase0(const P& p, char* lds) {
  const int tid = TID();
  if (BID() == 0) {
    float* rope = (float*)(p.ws + WS_ROPE);
    for (int e = tid; e < 1024; e += 256) {
      int pos = e >> 4, f = e & 15;
      float inv = powf(10000.f, -(float)f / 16.f);
      float ang = (float)pos * inv;
      rope[e * 2] = cosf(ang); rope[e * 2 + 1] = sinf(ang);
    }
  }
  float* sc = (float*)lds;
  float* red = sc + 5120;
  float* MOD = (float*)(p.ws + WS_MOD);
  bool loaded = false;
  for (int it = BID(); it < 384; it += gridDim.x) {
    if (!loaded) {
      for (int e = tid; e < 5120; e += 256) {
        int c = e >> 10, k = e & 1023;
        float v = (c == 0) ? p.in[7][k] : p.in[6][(c - 1) * 1024 + k];
        sc[e] = siluf_(v);
      }
      __syncthreads();
      loaded = true;
    }
    const int l = it / 96, c0 = (it % 96) * 64;
    const int col = c0 + (tid & 63), kg = tid >> 6;
    const float* W = p.in[10] + (size_t)l * 1024 * 6144 + col;
    float acc[5] = {0.f, 0.f, 0.f, 0.f, 0.f};
#pragma unroll 16
    for (int k = kg * 256; k < kg * 256 + 256; ++k) {
      float wv = W[(size_t)k * 6144];
#pragma unroll
      for (int c = 0; c < 5; ++c) acc[c] += sc[c * 1024 + k] * wv;
    }
#pragma unroll
    for (int c = 0; c < 5; ++c) red[(kg * 5 + c) * 64 + (tid & 63)] = acc[c];
    __syncthreads();
    for (int e = tid; e < 320; e += 256) {
      int c = e >> 6, cc = e & 63;
      float s = red[(0 * 5 + c) * 64 + cc] + red[(1 * 5 + c) * 64 + cc] + red[(2 * 5 + c) * 64 + cc] + red[(3 * 5 + c) * 64 + cc];
      MOD[(l * 5 + c) * 6144 + c0 + cc] = s + p.in[11][l * 6144 + c0 + cc];
    }
    __syncthreads();
  }
}

__device__ __forceinline__ void transpose_item(const float* W, int K, int N, bf16_t* WT, int item, char* lds, bool remap = false) {
  float* tile = (float*)lds;
  const int tid = TID();
  const int nblk = N >> 5, kb = item / nblk, nbk = item - kb * nblk, k0 = kb * 64, n0 = nbk * 32;
  __syncthreads();
  {
    const int kr = tid >> 3, c4 = (tid & 7) * 4;
#pragma unroll
    for (int ps = 0; ps < 2; ++ps) {
      float4 v = *(const float4*)(W + (size_t)(k0 + kr + 32 * ps) * N + n0 + c4);
      float* d = tile + (kr + 32 * ps) * 33 + c4;
      d[0] = v.x; d[1] = v.y; d[2] = v.z; d[3] = v.w;
    }
  }
  __syncthreads();
  {
    const int n = tid >> 3, kc = (tid & 7) * 8;
    float x[8];
#pragma unroll
    for (int e = 0; e < 8; ++e) x[e] = tile[(kc + e) * 33 + n];
    const int r0 = remap ? (((n0 % DFF) >> 6) * 128 + (n0 >= DFF ? 64 : 0) + (n0 & 63)) : n0;
    *(uint4*)(WT + (size_t)(r0 + n) * K + k0 + kc) = pack8(x);
  }
}

__device__ __forceinline__ void convert_weights(const P& p, int layer, char* lds) {
  bf16_t* WB = (bf16_t*)(p.ws + WS_WB);
  const int jl = layer >> 1;
  const bool even = (layer & 1) == 0;
  const int n_in = even ? 16 * 73 : 16 * 64;
  const int n_out = 16 * 32, n_up = 16 * 176, n_down = 44 * 32;
  const int n_extra = even ? 96 : 128;
  const int total = n_in + n_out + n_up + n_down + n_extra;
  for (int it = BID(); it < total; it += gridDim.x) {
    int r = it;
    if (r < n_in) {
      if (even) transpose_item(p.in[12] + (size_t)jl * 1024 * EV_IN, 1024, EV_IN, WB + WB_IN, r, lds);
      else transpose_item(p.in[20] + (size_t)jl * 1024 * 2048, 1024, 2048, WB + WB_IN, r, lds);
      continue;
    }
    r -= n_in;
    if (r < n_out) {
      transpose_item((even ? p.in[19] : p.in[28]) + (size_t)jl * 1024 * 1024, 1024, 1024, WB + WB_OUT, r, lds);
      continue;
    }
    r -= n_out;
    if (r < n_up) { transpose_item(p.in[29] + (size_t)layer * 1024 * DFF2, 1024, DFF2, WB + WB_UP, r, lds, true); continue; }
    r -= n_up;
    if (r < n_down) { transpose_item(p.in[32] + (size_t)layer * DFF * 1024, DFF, 1024, WB + WB_DOWN, r, lds); continue; }
    r -= n_down;
    if (even) {
      uint2 z; z.x = 0; z.y = 0;
      *(uint2*)(WB + WB_IN + (size_t)(EV_IN + r) * 1024 + TID() * 4) = z;
    } else {
      const int mi = r >> 1, sub = r & 1;
      const int g = mi >> 5, dir = (mi >> 4) & 1, nb = mi & 15;
      const float* src = (g == 0 ? p.in[23] : p.in[25]) + ((size_t)((jl * 2 + dir) * 16 + nb)) * 4096;
      transpose_item(src, 64, 64, WB + WB_RG + (size_t)mi * 4096, sub, lds);
    }
  }
}

__device__ __forceinline__ const float* x_row(const P& p, bool from_inputs, int row) {
  return from_inputs ? (row < T_PROMPT ? p.in[0] + (size_t)row * 1024 : p.in[1] + (size_t)(row - T_PROMPT) * 1024) : p.out + (size_t)row * 1024;
}
__device__ __forceinline__ void norm_rows(const P& p, const float* g, const float* mod_l, int shift_idx, bool from_inputs) {
  const int tid = TID(), lane = tid & 63, wave = tid >> 6;
  bf16_t* H = (bf16_t*)(p.ws + WS_H);
  for (int row0 = (BID() * 4 + wave) * 2; row0 < T_ALL; row0 += gridDim.x * 8) {
    float4 v[2][4]; float ss[2];
#pragma unroll
    for (int r = 0; r < 2; ++r) {
      const float4* xr = (const float4*)x_row(p, from_inputs, row0 + r);
      ss[r] = 0.f;
#pragma unroll
      for (int j = 0; j < 4; ++j) { v[r][j] = xr[lane + 64 * j]; }
    }
#pragma unroll
    for (int r = 0; r < 2; ++r) {
#pragma unroll
      for (int j = 0; j < 4; ++j) ss[r] += v[r][j].x * v[r][j].x + v[r][j].y * v[r][j].y + v[r][j].z * v[r][j].z + v[r][j].w * v[r][j].w;
      ss[r] = wave_sum(ss[r]);
    }
#pragma unroll
    for (int r = 0; r < 2; ++r) {
      const int row = row0 + r;
      const float rstd = __builtin_amdgcn_rsqf(ss[r] * (1.f / 1024.f) + 1e-6f);
      const int cond = tok_cond(row);
      const float* sh = mod_l + cond * 6144 + shift_idx * 1024;
      const float* scl = sh + 1024;
#pragma unroll
      for (int j = 0; j < 4; ++j) {
        const int k = (lane + 64 * j) * 4;
        const float4 g4 = *(const float4*)(g + k), s4 = *(const float4*)(scl + k), h4 = *(const float4*)(sh + k);
        float o0 = v[r][j].x * rstd * g4.x * (1.f + s4.x) + h4.x;
        float o1 = v[r][j].y * rstd * g4.y * (1.f + s4.y) + h4.y;
        float o2 = v[r][j].z * rstd * g4.z * (1.f + s4.z) + h4.z;
        float o3 = v[r][j].w * rstd * g4.w * (1.f + s4.w) + h4.w;
        uint2 o; o.x = pack2(o0, o1); o.y = pack2(o2, o3);
        *(uint2*)(H + (size_t)row * 1024 + k) = o;
      }
    }
  }
}

__device__ __forceinline__ void final_norm(const P& p) {
  const int tid = TID(), lane = tid & 63, wave = tid >> 6;
  float* X = p.out;
  const float* g = p.in[33];
  for (int row = BID() * 4 + wave; row < T_ALL; row += gridDim.x * 4) {
    float4* xr = (float4*)(X + (size_t)row * 1024);
    float4 v[4]; float ss = 0.f;
#pragma unroll
    for (int j = 0; j < 4; ++j) { v[j] = xr[lane + 64 * j]; ss += v[j].x * v[j].x + v[j].y * v[j].y + v[j].z * v[j].z + v[j].w * v[j].w; }
    ss = wave_sum(ss);
    const float rstd = 1.f / sqrtf(ss * (1.f / 1024.f) + 1e-6f);
#pragma unroll
    for (int j = 0; j < 4; ++j) {
      const float4 g4 = *(const float4*)(g + (lane + 64 * j) * 4);
      float4 o; o.x = v[j].x * rstd * g4.x; o.y = v[j].y * rstd * g4.y; o.z = v[j].z * rstd * g4.z; o.w = v[j].w * rstd * g4.w;
      xr[lane + 64 * j] = o;
    }
  }
}

struct GemmArgs {
  const bf16_t* A; int lda; const bf16_t* Bt; int K; int M; int NP;
  int m_off;
  bf16_t* o16;
  float* X;
  const float* gate;
  float* outk; float* outv; int jl; int dry;
  const float* cw; const float* cb; float* halo;
  const float* x0p; const float* x0s;
  unsigned* qctr;
};

template <int EPI>
__device__ __forceinline__ void gemm_epi(const GemmArgs& g, int m, int n, f32x4 a) {
  if (EPI == 0) {
    if (n < EV_IN) {
      uint2 o; o.x = pack2(a[0], a[1]); o.y = pack2(a[2], a[3]);
      *(uint2*)(g.o16 + (size_t)m * EV_IN + n) = o;
      if (m < T_PROMPT && n >= 512 && n < 768) {
        const int b = m >> 8, s = m & 255;
        float4 f; f.x = a[0]; f.y = a[1]; f.z = a[2]; f.w = a[3];
        if (n < 640) *(float4*)(g.outk + ((size_t)((b * 2 + g.jl) * 256 + s)) * 128 + (n - 512)) = f;
        else *(float4*)(g.outv + ((size_t)((b * 2 + g.jl) * 256 + s)) * 128 + (n - 640)) = f;
      }
    }
  } else if (EPI == 1) {
    float v0 = a[0], v1 = a[1], v2 = a[2], v3 = a[3];
    if (n < 1024) { v0 = gelu_tanh(v0); v1 = gelu_tanh(v1); v2 = gelu_tanh(v2); v3 = gelu_tanh(v3); }
    uint2 o; o.x = pack2(v0, v1); o.y = pack2(v2, v3);
    *(uint2*)(g.o16 + (size_t)m * 2048 + n) = o;
  } else if (EPI == 2) {
    const int t = g.m_off + m;
    const float4 gt = *(const float4*)(g.gate + tok_cond(t) * 6144 + n);
    float4* xp = (float4*)(g.X + (size_t)t * 1024 + n);
    float4 x = g.x0p ? (t < T_PROMPT ? *(const float4*)(g.x0p + (size_t)t * 1024 + n) : *(const float4*)(g.x0s + (size_t)(t - T_PROMPT) * 1024 + n)) : *xp;
    x.x += gt.x * a[0]; x.y += gt.y * a[1]; x.z += gt.z * a[2]; x.w += gt.w * a[3];
    if (!g.dry) *xp = x;
  } else {
    uint2 o; o.x = pack2(a[0], a[1]); o.y = pack2(a[2], a[3]);
    *(uint2*)(g.o16 + (size_t)m * DFF2 + n) = o;
  }
}


__device__ __forceinline__ void ffn_conv8(const float (&g0)[8], const float (&g1)[8], const float (&g2)[8], const float (&v0)[8], const float (&v1)[8], const float (&v2)[8],
                                          const float (&wg)[3][8], const float (&wv)[3][8], const float (&bg)[8], const float (&bv)[8], float (&o)[8]) {
#pragma unroll
  for (int e = 0; e < 8; ++e) {
    const float gc = bg[e] + g0[e] * wg[0][e] + g1[e] * wg[1][e] + g2[e] * wg[2][e];
    const float vc = bv[e] + v0[e] * wv[0][e] + v1[e] * wv[1][e] + v2[e] * wv[2][e];
    o[e] = fsilu(gc) * vc;
  }
}
__device__ __forceinline__ void ld8(const float* p, float (&x)[8]) {
  const float4 a = *(const float4*)p, b = *(const float4*)(p + 4);
  x[0] = a.x; x[1] = a.y; x[2] = a.z; x[3] = a.w; x[4] = b.x; x[5] = b.y; x[6] = b.z; x[7] = b.w;
}
__device__ __forceinline__ void ffn_load_w(const float* cw, const float* cb, int ch, float (&wg)[3][8], float (&wv)[3][8], float (&bg)[8], float (&bv)[8]) {
#pragma unroll
  for (int j = 0; j < 3; ++j) { ld8(cw + j * DFF2 + ch, wg[j]); ld8(cw + j * DFF2 + DFF + ch, wv[j]); }
  ld8(cb + ch, bg); ld8(cb + DFF + ch, bv);
}
__device__ __forceinline__ void ld8h(const bf16_t* p, float (&x)[8]) { unpack8(*(const uint4*)p, x); }
__device__ __forceinline__ void ffn_tile_epilogue(const GemmArgs& g, const bf16_t* Ut, int m0, int nt, int tid) {
  const int c8 = (tid & 7) * 8, ts = (tid >> 3) * 4;
  const int ch = nt * 64 + c8;
  float wg[3][8], wv[3][8], bg[8], bv[8];
  ffn_load_w(g.cw, g.cb, ch, wg, wv, bg, bv);
  int s0, len; tok_seq(m0, s0, len);
  const bool seq_start = (m0 == s0), seq_end = (m0 + 128 == s0 + len);
  float g0[8], g1[8], g2[8], v0[8], v1[8], v2[8];
  if (ts > 0) { ld8h(Ut + (ts - 1) * 136 + c8, g0); ld8h(Ut + (ts - 1) * 136 + 64 + c8, v0); }
  else {
#pragma unroll
    for (int e = 0; e < 8; ++e) { g0[e] = 0.f; v0[e] = 0.f; }
  }
  ld8h(Ut + ts * 136 + c8, g1); ld8h(Ut + ts * 136 + 64 + c8, v1);
#pragma unroll
  for (int ii = 0; ii < 4; ++ii) {
    const int t = ts + ii;
    if (t + 1 < 128) { ld8h(Ut + (t + 1) * 136 + c8, g2); ld8h(Ut + (t + 1) * 136 + 64 + c8, v2); }
    else {
#pragma unroll
      for (int e = 0; e < 8; ++e) { g2[e] = 0.f; v2[e] = 0.f; }
    }
    float o[8];
    ffn_conv8(g0, g1, g2, v0, v1, v2, wg, wv, bg, bv, o);
    const bool skip = (t == 0 && !seq_start) || (t == 127 && !seq_end);
    if (!skip) *(uint4*)(g.o16 + (size_t)(m0 + t) * DFF + ch) = pack8(o);
#pragma unroll
    for (int e = 0; e < 8; ++e) { g0[e] = g1[e]; g1[e] = g2[e]; v0[e] = v1[e]; v1[e] = v2[e]; }
  }
  if (tid < 128) {
    const int rs = tid >> 5, c4 = (tid & 31) * 4;
    const int row = rs < 2 ? rs : 124 + rs;
    const uint2 raw = *(const uint2*)(Ut + row * 136 + c4);
    *(float4*)(g.halo + ((size_t)((m0 >> 7) * 4 + rs)) * DFF2 + nt * 128 + c4) = make_float4(bflo(raw.x), bfhi(raw.x), bflo(raw.y), bfhi(raw.y));
  }
}
__device__ __forceinline__ void ffn_fixup(const P& p, int layer) {
  const float* HALO = (const float*)(p.ws + WS_STATES);
  bf16_t* ACT = (bf16_t*)(p.ws + WS_REGION);
  const float* cw = p.in[30] + (size_t)layer * 3 * DFF2;
  const float* cb = p.in[31] + (size_t)layer * DFF2;
  const int total = 191 * 2 * 352;
  for (int idx = BID() * 256 + TID(); idx < total; idx += gridDim.x * 256) {
    const int kg = idx % 352, r = idx / 352;
    const int side = r & 1, mt = r >> 1;
    const int tb = (mt + 1) * 128;
    const bool is_start = tb < T_PROMPT ? ((tb & 255) == 0) : (((tb - T_PROMPT) & 4095) == 0);
    if (is_start) continue;
    const int ch = kg * 8;
    const int hc = (ch >> 6) * 128 + (ch & 63);
    float wg[3][8], wv[3][8], bg[8], bv[8];
    ffn_load_w(cw, cb, ch, wg, wv, bg, bv);
    const float* r0 = HALO + ((size_t)(mt * 4 + (side == 0 ? 2 : 3))) * DFF2 + hc;
    const float* r1 = side == 0 ? HALO + ((size_t)(mt * 4 + 3)) * DFF2 + hc : HALO + ((size_t)((mt + 1) * 4 + 0)) * DFF2 + hc;
    const float* r2 = HALO + ((size_t)((mt + 1) * 4 + (side == 0 ? 0 : 1))) * DFF2 + hc;
    float g0[8], g1[8], g2[8], v0[8], v1[8], v2[8], o[8];
    ld8(r0, g0); ld8(r0 + 64, v0); ld8(r1, g1); ld8(r1 + 64, v1); ld8(r2, g2); ld8(r2 + 64, v2);
    ffn_conv8(g0, g1, g2, v0, v1, v2, wg, wv, bg, bv, o);
    const int t = side == 0 ? tb - 1 : tb;
    *(uint4*)(ACT + (size_t)t * DFF + ch) = pack8(o);
  }
}

__device__ __forceinline__ int gemm_fetch_tile(unsigned* qc, int q0, int nq) {
  for (int k = 0; k < 8; ++k) {
    const int qq = (q0 + k) & 7;
    const unsigned idx = __hip_atomic_fetch_add(qc + qq * 16, 1u, __ATOMIC_RELAXED, __HIP_MEMORY_SCOPE_AGENT);
    if (idx < (unsigned)nq) return qq * nq + (int)idx;
  }
  return -1;
}

template <int EPI>
__device__ __forceinline__ void gemm_phase(const GemmArgs& g, char* lds) {
  bf16_t* sAb = (bf16_t*)lds;
  LAS char* ldsl = (LAS char*)lds;
  bf16_t* sBb = sAb + 2 * 128 * 64;
  const int tid = TID(), lane = tid & 63, w = __builtin_amdgcn_readfirstlane(tid >> 6);
  const int wm = (w & 1) * 64, wn = (w >> 1) * 64;
  const int ntn = g.NP >> 7, ntm = g.M >> 7;
  const int KT = g.K >> 6;
  const int lrow = tid >> 3, lkc = (tid & 7) * 8;
  const int skc = ((tid & 7) ^ ((lrow >> 1) & 7)) * 8;
  const int band = 8 * ntn;
  const int nq = (ntm * ntn) >> 3;
  const int q0 = (int)((unsigned)__builtin_amdgcn_s_getreg((3 << 11) | 20) & 7u);
  volatile int* slot = (volatile int*)(lds - 16) + 2;
  if (tid == 0) *slot = gemm_fetch_tile(g.qctr, q0, nq);
  __syncthreads();
  int tile = __builtin_amdgcn_readfirstlane(*slot);
  while (tile >= 0) {
    const int bd = tile / band, within = tile - bd * band;
    const int nt = within >> 3, mt = bd * 8 + (within & 7);
    const int m0 = mt << 7, n0 = nt << 7;
    const bf16_t* gA = g.A + (size_t)(m0 + lrow) * g.lda + skc;
    const bf16_t* gB = g.Bt + (size_t)(n0 + lrow) * g.K + skc;
    const size_t sa32 = (size_t)32 * g.lda, sb32 = (size_t)32 * g.K;
    f32x4 acc[4][4];
#pragma unroll
    for (int a = 0; a < 4; ++a)
#pragma unroll
      for (int c = 0; c < 4; ++c) acc[a][c] = (f32x4){0.f, 0.f, 0.f, 0.f};
#define GLDS_TILE(kt_, buf_) do { \
      const bf16_t* a2_ = gA + (size_t)(kt_) * 64; const bf16_t* b2_ = gB + (size_t)(kt_) * 64; \
      LAS char* dA_ = ldsl + (buf_) * 16384 + w * 1024; LAS char* dB_ = ldsl + 32768 + (buf_) * 16384 + w * 1024; \
      _Pragma("unroll") for (int i_ = 0; i_ < 4; ++i_) { \
        __builtin_amdgcn_global_load_lds((const unsigned*)(a2_ + i_ * sa32), (LAS unsigned*)(dA_ + i_ * 4096), 16, 0, 0); \
        __builtin_amdgcn_global_load_lds((const unsigned*)(b2_ + i_ * sb32), (LAS unsigned*)(dB_ + i_ * 4096), 16, 0, 0); } } while (0)
    GLDS_TILE(0, 0);
    asm volatile("s_waitcnt vmcnt(0)" ::: "memory");
    __syncthreads();
    int nxt = -1;
    if (tid == 0) nxt = gemm_fetch_tile(g.qctr, q0, nq);
    for (int kt = 0; kt < KT; ++kt) {
      if (kt == 1 && tid == 0) *slot = nxt;
      const bf16_t* sA = sAb + (kt & 1) * (128 * 64);
      const bf16_t* sB = sBb + (kt & 1) * (128 * 64);
#pragma unroll
      for (int ks = 0; ks < 2; ++ks) {
        bf16x8 bfr[4], afr[4];
#pragma unroll
        for (int im = 0; im < 4; ++im) bfr[im] = frag_sw(sA, wm + im * 16, ks, lane);
#pragma unroll
        for (int jn = 0; jn < 4; ++jn) afr[jn] = frag_sw(sB, wn + jn * 16, ks, lane);
        if (ks == 0 && kt + 1 < KT) GLDS_TILE(kt + 1, (kt + 1) & 1);
        __builtin_amdgcn_s_setprio(1);
#pragma unroll
        for (int jn = 0; jn < 4; ++jn)
#pragma unroll
          for (int im = 0; im < 4; ++im) acc[jn][im] = mfma16(afr[jn], bfr[im], acc[jn][im]);
        __builtin_amdgcn_s_setprio(0);
      }
      asm volatile("s_waitcnt vmcnt(0)" ::: "memory");
      __syncthreads();
    }
#undef GLDS_TILE
    const int tile_next = __builtin_amdgcn_readfirstlane(*slot);
    if (EPI == 3) {
      bf16_t* Ut = (bf16_t*)lds;
#pragma unroll
      for (int jn = 0; jn < 4; ++jn)
#pragma unroll
        for (int im = 0; im < 4; ++im) {
          uint2 o; o.x = pack2(acc[jn][im][0], acc[jn][im][1]); o.y = pack2(acc[jn][im][2], acc[jn][im][3]);
          *(uint2*)(Ut + (wm + im * 16 + (lane & 15)) * 136 + wn + jn * 16 + (lane >> 4) * 4) = o;
        }
      __syncthreads();
      ffn_tile_epilogue(g, Ut, m0, nt, tid);
      __syncthreads();
    } else {
#pragma unroll
      for (int jn = 0; jn < 4; ++jn)
#pragma unroll
        for (int im = 0; im < 4; ++im)
          gemm_epi<EPI>(g, m0 + wm + im * 16 + (lane & 15), n0 + wn + jn * 16 + (lane >> 4) * 4, acc[jn][im]);
    }
    tile = tile_next;
  }
}

#define ATT_ROPE_OFF ((128 + 64 + 64 + 128) * 72 * 2)
__device__ __forceinline__ void attn_stage_rope(const P& p, char* lds) {
  const float* rope = (const float*)(p.ws + WS_ROPE);
  float* rl = (float*)(lds + ATT_ROPE_OFF);
  const int tid = TID();
  __syncthreads();
#pragma unroll
  for (int e = 0; e < 8; ++e) rl[tid + 256 * e] = rope[tid + 256 * e];
  __syncthreads();
}
__device__ __forceinline__ void rope16(float* x, const float* y, const float* rl, int idx, int sg) {
#pragma unroll
  for (int e = 0; e < 16; ++e) {
    const float2 cs = *(const float2*)(rl + (idx * 16 + e) * 2);
    x[e] = (sg & 1) ? (y[e] * cs.y + x[e] * cs.x) : (x[e] * cs.x - y[e] * cs.y);
  }
}
__device__ __forceinline__ void unpackf4(uint4 r, float* x) {
  x[0] = __uint_as_float(r.x); x[1] = __uint_as_float(r.y); x[2] = __uint_as_float(r.z); x[3] = __uint_as_float(r.w);
}
__device__ __forceinline__ void attn_item(const P& p, int item, int jl, char* lds) {
  bf16_t* Qs = (bf16_t*)lds; bf16_t* Ks = Qs + 128 * 72; bf16_t* VT = Ks + 64 * 72; bf16_t* Ps = VT + 64 * 72;
  const float* rl = (const float*)(lds + ATT_ROPE_OFF);
  const bf16_t* PJ = (const bf16_t*)(p.ws + WS_REGION);
  bf16_t* MIX = (bf16_t*)(p.ws + WS_H);
  const int tid = TID(), lane = tid & 63, w = tid >> 6;
  bool latent; int seq, q0, hq;
  if (item < 1024) { latent = true; hq = item & 7; int r = item >> 3; q0 = (r & 31) * 128; seq = r >> 5; }
  else { latent = false; int r = item - 1024; hq = r & 7; r >>= 3; q0 = (r & 1) * 128; seq = r >> 1; }
  const int tbase = latent ? T_PROMPT + seq * 4096 : seq * 256;
  const int kvh = hq >> 2;
  const int u_lo = latent ? (q0 >= 128 ? 0 : (128 - q0) >> 6) : 0;
  const int u_hi = latent ? ((4160 - q0) >> 6 < 5 ? (4160 - q0) >> 6 : 5) : 3;
  const int nw = u_hi - u_lo + 1;
  const int ntiles = latent ? nw + 4 : 4;
  const int krow = tid >> 2, ksg = tid & 3, vkey = tid & 63, vsg = tid >> 6;
  uint4 k0, k1, k2, k3, v0, v1, v2, v3;
  k0 = k1 = k2 = k3 = v0 = v1 = v2 = v3 = make_uint4(0u, 0u, 0u, 0u);
#define ATT_TILE(j_, mode_, kp0_) do { if (latent) { if ((j_) < nw) { mode_ = 0; kp0_ = q0 - 128 + 64 * (u_lo + (j_)); } else { mode_ = 2; kp0_ = ((j_) - nw) * 64; } } else { mode_ = 1; kp0_ = (j_) * 64; } } while (0)
#define ATT_LOAD(j_) do { int mode_, kp0_; ATT_TILE(j_, mode_, kp0_); \
    if (mode_ == 2) { \
      const float* ks_ = p.in[2] + ((size_t)(((seq * 2 + jl) * 256 + kp0_ + krow) * 2 + kvh)) * 64 + ksg * 16; \
      const float* vs_ = p.in[3] + ((size_t)(((seq * 2 + jl) * 256 + kp0_ + vkey) * 2 + kvh)) * 64 + vsg * 16; \
      k0 = *(const uint4*)(ks_); k1 = *(const uint4*)(ks_ + 4); k2 = *(const uint4*)(ks_ + 8); k3 = *(const uint4*)(ks_ + 12); \
      v0 = *(const uint4*)(vs_); v1 = *(const uint4*)(vs_ + 4); v2 = *(const uint4*)(vs_ + 8); v3 = *(const uint4*)(vs_ + 12); \
    } else { \
      const bf16_t* ks_ = PJ + (size_t)(tbase + kp0_ + krow) * EV_IN + 512 + kvh * 64; \
      const bf16_t* vs_ = PJ + (size_t)(tbase + kp0_ + vkey) * EV_IN + 640 + kvh * 64 + vsg * 16; \
      k0 = *(const uint4*)(ks_ + ksg * 16); k1 = *(const uint4*)(ks_ + ksg * 16 + 8); \
      if (mode_ == 0) { k2 = *(const uint4*)(ks_ + (ksg ^ 1) * 16); k3 = *(const uint4*)(ks_ + (ksg ^ 1) * 16 + 8); } \
      v0 = *(const uint4*)(vs_); v1 = *(const uint4*)(vs_ + 8); \
    } } while (0)
  ATT_LOAD(0);
  __syncthreads();
#pragma unroll
  for (int hh = 0; hh < 2; ++hh) {
    const int qr = krow + 64 * hh;
    const bf16_t* src = PJ + (size_t)(tbase + q0 + qr) * EV_IN + hq * 64;
    if (latent) {
      float x[16], y[16];
      unpack8(*(const uint4*)(src + ksg * 16), x); unpack8(*(const uint4*)(src + ksg * 16 + 8), x + 8);
      unpack8(*(const uint4*)(src + (ksg ^ 1) * 16), y); unpack8(*(const uint4*)(src + (ksg ^ 1) * 16 + 8), y + 8);
      const int pos = q0 + qr;
      rope16(x, y, rl, (ksg < 2) ? (pos >> 6) : (pos & 63), ksg);
      *(uint4*)(Qs + qr * 72 + ksg * 16) = pack8(x);
      *(uint4*)(Qs + qr * 72 + ksg * 16 + 8) = pack8(x + 8);
    } else {
      *(uint4*)(Qs + qr * 72 + ksg * 16) = *(const uint4*)(src + ksg * 16);
      *(uint4*)(Qs + qr * 72 + ksg * 16 + 8) = *(const uint4*)(src + ksg * 16 + 8);
    }
  }
  const float SC = 0.125f * LOG2E;
  const float sinkl = p.in[13][jl * 8 + hq] * LOG2E;
  float m_run[2] = {sinkl, sinkl}, l_run[2] = {1.f, 1.f};
  f32x4 oacc[2][4];
#pragma unroll
  for (int g = 0; g < 2; ++g)
#pragma unroll
    for (int i = 0; i < 4; ++i) oacc[g][i] = (f32x4){0.f, 0.f, 0.f, 0.f};
  for (int j = 0; j < ntiles; ++j) {
    int mode, kp0; ATT_TILE(j, mode, kp0);
    if (j > 0) __syncthreads();
    {
      float x[16];
      if (mode == 1) {
        *(uint4*)(Ks + krow * 72 + ksg * 16) = k0;
        *(uint4*)(Ks + krow * 72 + ksg * 16 + 8) = k1;
      } else {
        if (mode == 2) { unpackf4(k0, x); unpackf4(k1, x + 4); unpackf4(k2, x + 8); unpackf4(k3, x + 12); }
        else {
          unpack8(k0, x); unpack8(k1, x + 8);
          float y[16]; unpack8(k2, y); unpack8(k3, y + 8);
          const int pos = kp0 + krow;
          rope16(x, y, rl, (ksg < 2) ? (pos >> 6) : (pos & 63), ksg);
        }
        *(uint4*)(Ks + krow * 72 + ksg * 16) = pack8(x);
        *(uint4*)(Ks + krow * 72 + ksg * 16 + 8) = pack8(x + 8);
      }
      if (mode == 2) {
        unpackf4(v0, x); unpackf4(v1, x + 4); unpackf4(v2, x + 8); unpackf4(v3, x + 12);
#pragma unroll
        for (int e = 0; e < 8; ++e) {
          const unsigned int pk = pack2(x[2 * e], x[2 * e + 1]);
          VT[(vsg * 16 + 2 * e) * 72 + vkey] = (bf16_t)(pk & 0xffffu);
          VT[(vsg * 16 + 2 * e + 1) * 72 + vkey] = (bf16_t)(pk >> 16);
        }
      } else {
        const unsigned int u[8] = {v0.x, v0.y, v0.z, v0.w, v1.x, v1.y, v1.z, v1.w};
#pragma unroll
        for (int e = 0; e < 8; ++e) {
          VT[(vsg * 16 + 2 * e) * 72 + vkey] = (bf16_t)(u[e] & 0xffffu);
          VT[(vsg * 16 + 2 * e + 1) * 72 + vkey] = (bf16_t)(u[e] >> 16);
        }
      }
    }
    if (j + 1 < ntiles) ATT_LOAD(j + 1);
    __syncthreads();
    const bool need_mask = (mode == 0) && (kp0 != q0) && (kp0 != q0 + 64);
#pragma unroll
    for (int g = 0; g < 2; ++g) {
      const int qi = 32 * w + 16 * g + (lane & 15);
      f32x4 s[4];
#pragma unroll
      for (int i = 0; i < 4; ++i) s[i] = (f32x4){0.f, 0.f, 0.f, 0.f};
      __builtin_amdgcn_s_setprio(1);
#pragma unroll
      for (int ks = 0; ks < 2; ++ks) {
        const bf16x8 bq = frag(Qs, 32 * w + 16 * g, ks, lane);
#pragma unroll
        for (int kt = 0; kt < 4; ++kt) s[kt] = mfma16(frag(Ks, kt * 16, ks, lane), bq, s[kt]);
      }
      __builtin_amdgcn_s_setprio(0);
      float mx = -3.0e38f;
#pragma unroll
      for (int kt = 0; kt < 4; ++kt)
#pragma unroll
        for (int r = 0; r < 4; ++r) {
          float v = s[kt][r] * SC;
          if (need_mask) {
            const int kp = kp0 + kt * 16 + (lane >> 4) * 4 + r;
            const int dlt = kp - (q0 + qi);
            if (dlt > 128 || dlt < -128) v = -1.0e30f;
          }
          s[kt][r] = v; mx = fmaxf(mx, v);
        }
      mx = fmaxf(mx, __shfl_xor(mx, 16)); mx = fmaxf(mx, __shfl_xor(mx, 32));
      const float m_new = fmaxf(m_run[g], mx);
      const float alpha = __builtin_amdgcn_exp2f(m_run[g] - m_new);
      float rs = 0.f;
#pragma unroll
      for (int kt = 0; kt < 4; ++kt) {
        float p0 = __builtin_amdgcn_exp2f(s[kt][0] - m_new), p1 = __builtin_amdgcn_exp2f(s[kt][1] - m_new), p2 = __builtin_amdgcn_exp2f(s[kt][2] - m_new), p3 = __builtin_amdgcn_exp2f(s[kt][3] - m_new);
        rs += (p0 + p1) + (p2 + p3);
        uint2 o; o.x = pack2(p0, p1); o.y = pack2(p2, p3);
        *(uint2*)(Ps + qi * 72 + kt * 16 + (lane >> 4) * 4) = o;
      }
      rs += __shfl_xor(rs, 16); rs += __shfl_xor(rs, 32);
      l_run[g] = l_run[g] * alpha + rs; m_run[g] = m_new;
#pragma unroll
      for (int i = 0; i < 4; ++i) { oacc[g][i][0] *= alpha; oacc[g][i][1] *= alpha; oacc[g][i][2] *= alpha; oacc[g][i][3] *= alpha; }
    }
    __syncthreads();
    __builtin_amdgcn_s_setprio(1);
#pragma unroll
    for (int g = 0; g < 2; ++g)
#pragma unroll
      for (int ks = 0; ks < 2; ++ks) {
        const bf16x8 bp = frag(Ps, 32 * w + 16 * g, ks, lane);
#pragma unroll
        for (int dt = 0; dt < 4; ++dt) oacc[g][dt] = mfma16(frag(VT, dt * 16, ks, lane), bp, oacc[g][dt]);
      }
    __builtin_amdgcn_s_setprio(0);
  }
#undef ATT_LOAD
#undef ATT_TILE
#pragma unroll
  for (int g = 0; g < 2; ++g) {
    const int qi = 32 * w + 16 * g + (lane & 15);
    const float inv = __builtin_amdgcn_rcpf(l_run[g]);
#pragma unroll
    for (int dt = 0; dt < 4; ++dt) {
      uint2 o; o.x = pack2(oacc[g][dt][0] * inv, oacc[g][dt][1] * inv); o.y = pack2(oacc[g][dt][2] * inv, oacc[g][dt][3] * inv);
      *(uint2*)(MIX + (size_t)(tbase + q0 + qi) * 1024 + hq * 64 + dt * 16 + (lane >> 4) * 4) = o;
    }
  }
}

__device__ __forceinline__ uint2 gla_r_load(const bf16_t* PJ, int t0, int dir, int tid) {
  const int i = tid >> 2, r4 = (tid & 3) * 4;
  return *(const uint2*)(PJ + (size_t)(t0 + i) * EV_IN + 2304 + dir * 16 + r4);
}
__device__ __forceinline__ void gla_r_store(uint2 raw, float* rt, int tid) {
  const int i = tid >> 2, r4 = (tid & 3) * 4;
  rt[i * 16 + r4] = bflo(raw.x); rt[i * 16 + r4 + 1] = bfhi(raw.x); rt[i * 16 + r4 + 2] = bflo(raw.y); rt[i * 16 + r4 + 3] = bfhi(raw.y);
}
__device__ __forceinline__ void gla_gates(const P& p, int h, int dir, int jl, const float* rt, float* seg, float* b, float& tot) {
  const int tid = TID();
  const int d = tid & 63, q = tid >> 6;
  const float* wg = (dir == 0 ? p.in[14] : p.in[16]) + jl * 16 * 256 + h * 64 + d;
  const float bias = (dir == 0 ? p.in[15] : p.in[17])[jl * 256 + h * 64 + d];
  float wv[16];
#pragma unroll
  for (int r = 0; r < 16; ++r) wv[r] = wg[r * 256];
#pragma unroll
  for (int ii = 0; ii < 16; ++ii) {
    const float* rr = rt + (16 * q + ii) * 16;
    float z = bias;
#pragma unroll
    for (int r = 0; r < 16; ++r) z += rr[r] * wv[r];
    b[ii] = flogsig(z) * (1.f / 16.f);
  }
  float run = 0.f;
  if (dir == 0) {
#pragma unroll
    for (int ii = 0; ii < 16; ++ii) { run += b[ii]; b[ii] = run; }
  } else {
#pragma unroll
    for (int ii = 15; ii >= 0; --ii) { run += b[ii]; b[ii] = run; }
  }
  seg[q * 64 + d] = run;
  __syncthreads();
  const float s0 = seg[d], s1 = seg[64 + d], s2 = seg[128 + d], s3 = seg[192 + d];
  tot = (s0 + s1) + (s2 + s3);
  float off;
  if (dir == 0) off = (q > 0 ? s0 : 0.f) + (q > 1 ? s1 : 0.f) + (q > 2 ? s2 : 0.f);
  else off = (q < 3 ? s3 : 0.f) + (q < 2 ? s2 : 0.f) + (q < 1 ? s1 : 0.f);
#pragma unroll
  for (int ii = 0; ii < 16; ++ii) b[ii] += off;
}

__device__ __forceinline__ void gla_pass1_item(const P& p, int item, int jl, char* lds) {
  float* rt = (float*)lds; float* rt2 = rt + 1024; float* seg = rt2 + 1024;
  bf16_t* KtT = (bf16_t*)(seg + 256);
  bf16_t* VT = KtT + 64 * 72;
  const bf16_t* PJ = (const bf16_t*)(p.ws + WS_REGION);
  bf16_t* STATES = (bf16_t*)(p.ws + WS_STATES);
  float* GA = (float*)(p.ws + WS_GLA_A);
  const int tid = TID(), lane = tid & 63, w = tid >> 6;
  const int h = item & 3, cgk = item >> 2;
  const int t0 = cgk * 64;
  const int d = tid & 63, q = tid >> 6;
  const uint2 r0 = gla_r_load(PJ, t0, 0, tid), r1 = gla_r_load(PJ, t0, 1, tid);
  float kraw[16];
#pragma unroll
  for (int ii = 0; ii < 16; ++ii) kraw[ii] = bf2f(PJ[(size_t)(t0 + 16 * q + ii) * EV_IN + 1024 + h * 64 + d]);
  uint4 vraw[4];
  {
    const bf16_t* src = PJ + (size_t)(t0 + (tid & 63)) * EV_IN + 1280 + h * 128 + (tid >> 6) * 32;
#pragma unroll
    for (int c = 0; c < 4; ++c) vraw[c] = *(const uint4*)(src + c * 8);
  }
  __syncthreads();
  gla_r_store(r0, rt, tid); gla_r_store(r1, rt2, tid);
  {
    const int i = tid & 63, sg = tid >> 6;
#pragma unroll
    for (int c = 0; c < 4; ++c) {
      const unsigned int u[4] = {vraw[c].x, vraw[c].y, vraw[c].z, vraw[c].w};
#pragma unroll
      for (int e = 0; e < 4; ++e) {
        VT[(sg * 32 + c * 8 + 2 * e) * 72 + i] = (bf16_t)(u[e] & 0xffffu);
        VT[(sg * 32 + c * 8 + 2 * e + 1) * 72 + i] = (bf16_t)(u[e] >> 16);
      }
    }
  }
  __syncthreads();
#pragma unroll
  for (int dir = 0; dir < 2; ++dir) {
    float b[16], tot;
    gla_gates(p, h, dir, jl, dir == 0 ? rt : rt2, seg, b, tot);
    {
      float kt[16];
#pragma unroll
      for (int ii = 0; ii < 16; ++ii) kt[ii] = kraw[ii] * __expf(tot - b[ii]);
      *(uint4*)(KtT + d * 72 + 16 * q) = pack8(kt);
      *(uint4*)(KtT + d * 72 + 16 * q + 8) = pack8(kt + 8);
    }
    __syncthreads();
    f32x4 acc[8];
#pragma unroll
    for (int i = 0; i < 8; ++i) acc[i] = (f32x4){0.f, 0.f, 0.f, 0.f};
#pragma unroll
    for (int ks = 0; ks < 2; ++ks) {
      const bf16x8 ak = frag(KtT, 16 * w, ks, lane);
#pragma unroll
      for (int vt = 0; vt < 8; ++vt) acc[vt] = mfma16(ak, frag(VT, vt * 16, ks, lane), acc[vt]);
    }
    const size_t sidx = (size_t)((cgk * 4 + h) * 2 + dir);
#pragma unroll
    for (int vt = 0; vt < 8; ++vt) {
      uint2 o; o.x = pack2(acc[vt][0], acc[vt][1]); o.y = pack2(acc[vt][2], acc[vt][3]);
      *(uint2*)(STATES + sidx * 8192 + (vt * 16 + (lane & 15)) * 64 + 16 * w + (lane >> 4) * 4) = o;
    }
    if (tid < 64) GA[sidx * 64 + tid] = __expf(tot);
    __syncthreads();
  }
}

__device__ __forceinline__ void gla_pass2_item(const P& p, int item, int jl, int dry = 0) {
  bf16_t* STATES = (bf16_t*)(p.ws + WS_STATES);
  const float* GA = (const float*)(p.ws + WS_GLA_A);
  const int tid = TID();
  bool sample; int stream, slab;
  if (item < 256) { sample = true; stream = item >> 3; slab = item & 7; }
  else { sample = false; stream = (item - 256) >> 3; slab = item & 7; }
  const int dir = stream & 1, h = (stream >> 1) & 3, sq = stream >> 3;
  const int chunk0 = sample ? 128 + sq * 64 : sq * 4;
  const int nch = sample ? 64 : 4;
  const int e = slab * 1024 + tid * 4;
  const int v = e >> 6, d = e & 63;
  float4 s = make_float4(0.f, 0.f, 0.f, 0.f);
  if (sample) {
    const float* S0 = p.in[4] + ((size_t)(((sq * 2 + jl) * 2 + dir) * 4 + h)) * 8192;
    s.x = S0[(d + 0) * 128 + v]; s.y = S0[(d + 1) * 128 + v]; s.z = S0[(d + 2) * 128 + v]; s.w = S0[(d + 3) * 128 + v];
  }
  for (int base = 0; base < nch; base += 4) {
    float4 dS[4], a[4]; size_t sx[4];
#pragma unroll
    for (int k = 0; k < 4; ++k) {
      const int c = dir == 0 ? chunk0 + base + k : chunk0 + nch - 1 - (base + k);
      sx[k] = (size_t)((c * 4 + h) * 2 + dir);
      { const uint2 raw = *(const uint2*)(STATES + sx[k] * 8192 + e); dS[k] = make_float4(bflo(raw.x), bfhi(raw.x), bflo(raw.y), bfhi(raw.y)); }
      a[k] = *(const float4*)(GA + sx[k] * 64 + d);
    }
#pragma unroll
    for (int k = 0; k < 4; ++k) {
      if (!dry) { uint2 o; o.x = pack2(s.x, s.y); o.y = pack2(s.z, s.w); *(uint2*)(STATES + sx[k] * 8192 + e) = o; }
      s.x = a[k].x * s.x + dS[k].x; s.y = a[k].y * s.y + dS[k].y; s.z = a[k].z * s.z + dS[k].z; s.w = a[k].w * s.w + dS[k].w;
    }
  }
  if (!sample && !dry) {
    float* o = p.out + OUT_GLA + ((size_t)(((sq * 2 + jl) * 2 + dir) * 4 + h)) * 8192;
    o[(d + 0) * 128 + v] = s.x; o[(d + 1) * 128 + v] = s.y; o[(d + 2) * 128 + v] = s.z; o[(d + 3) * 128 + v] = s.w;
  }
}

__device__ __forceinline__ void gla_pass3_item(const P& p, int item, int jl, char* lds) {
  float* rt = (float*)lds; float* seg = rt + 1024;
  bf16_t* Qs = (bf16_t*)(seg + 256); bf16_t* Ks = Qs + 64 * 72; bf16_t* VT = Ks + 64 * 72; bf16_t* ST = VT + 128 * 72; bf16_t* Ps = ST + 128 * 72;
  const bf16_t* PJ = (const bf16_t*)(p.ws + WS_REGION);
  const bf16_t* STATES = (const bf16_t*)(p.ws + WS_STATES);
  bf16_t* MIX = (bf16_t*)(p.ws + WS_H);
  const int tid = TID(), lane = tid & 63, w = tid >> 6;
  const int h = item & 3, cgk = item >> 2;
  const int t0 = cgk * 64;
  uint4 vraw[4];
  {
    const int i = tid & 63, sg = tid >> 6;
    const bf16_t* src = PJ + (size_t)(t0 + i) * EV_IN + 1280 + h * 128 + sg * 32;
#pragma unroll
    for (int c = 0; c < 4; ++c) vraw[c] = *(const uint4*)(src + c * 8);
  }
  f32x4 acc[8];
#pragma unroll
  for (int i = 0; i < 8; ++i) acc[i] = (f32x4){0.f, 0.f, 0.f, 0.f};
  const int iq = 16 * w + (lane & 15);
#pragma unroll
  for (int dir = 0; dir < 2; ++dir) {
    const uint2 rr = gla_r_load(PJ, t0, dir, tid);
    const int lrow = tid >> 2, lsg = (tid & 3) * 16;
    const bf16_t* qsrc = PJ + (size_t)(t0 + lrow) * EV_IN + 768 + h * 64 + lsg;
    const uint4 q0 = *(const uint4*)qsrc, q1 = *(const uint4*)(qsrc + 8), k0 = *(const uint4*)(qsrc + 256), k1 = *(const uint4*)(qsrc + 264);
    const size_t sidx = (size_t)((cgk * 4 + h) * 2 + dir);
    const bf16_t* stp = STATES + sidx * 8192 + tid * 8;
    const uint4 st0 = *(const uint4*)(stp), st1 = *(const uint4*)(stp + 2048), st2 = *(const uint4*)(stp + 4096), st3 = *(const uint4*)(stp + 6144);
    __syncthreads();
    gla_r_store(rr, rt, tid);
    *(uint4*)(Qs + lrow * 72 + lsg) = q0; *(uint4*)(Qs + lrow * 72 + lsg + 8) = q1;
    *(uint4*)(Ks + lrow * 72 + lsg) = k0; *(uint4*)(Ks + lrow * 72 + lsg + 8) = k1;
    {
      const int e0 = tid * 8;
      bf16_t* dp = ST + (e0 >> 6) * 72 + (e0 & 63);
      *(uint4*)(dp) = st0; *(uint4*)(dp + 32 * 72) = st1; *(uint4*)(dp + 64 * 72) = st2; *(uint4*)(dp + 96 * 72) = st3;
    }
    if (dir == 0) {
      const int i = tid & 63, sg = tid >> 6;
#pragma unroll
      for (int c = 0; c < 4; ++c) {
        const unsigned int u[4] = {vraw[c].x, vraw[c].y, vraw[c].z, vraw[c].w};
#pragma unroll
        for (int e = 0; e < 4; ++e) {
          VT[(sg * 32 + c * 8 + 2 * e) * 72 + i] = (bf16_t)(u[e] & 0xffffu);
          VT[(sg * 32 + c * 8 + 2 * e + 1) * 72 + i] = (bf16_t)(u[e] >> 16);
        }
      }
    }
    __syncthreads();
    float b[16], tot;
    gla_gates(p, h, dir, jl, rt, seg, b, tot);
    {
      const int d = tid & 63, q = tid >> 6;
#pragma unroll
      for (int ii = 0; ii < 16; ++ii) {
        const int i = 16 * q + ii;
        const float qv = bf2f(Qs[i * 72 + d]), kv = bf2f(Ks[i * 72 + d]);
        Qs[i * 72 + d] = f2bf(qv * 0.125f * __expf(b[ii]));
        Ks[i * 72 + d] = f2bf(kv * __expf(-b[ii]));
      }
    }
    __syncthreads();
    f32x4 pa[4];
#pragma unroll
    for (int i = 0; i < 4; ++i) pa[i] = (f32x4){0.f, 0.f, 0.f, 0.f};
#pragma unroll
    for (int ks = 0; ks < 2; ++ks) {
      const bf16x8 bq = frag(Qs, 16 * w, ks, lane);
#pragma unroll
      for (int jt = 0; jt < 4; ++jt) pa[jt] = mfma16(frag(Ks, jt * 16, ks, lane), bq, pa[jt]);
    }
#pragma unroll
    for (int jt = 0; jt < 4; ++jt) {
      float pv[4];
#pragma unroll
      for (int r = 0; r < 4; ++r) {
        const int j = jt * 16 + (lane >> 4) * 4 + r;
        const bool keep = dir == 0 ? (j <= iq) : (j >= iq);
        pv[r] = keep ? pa[jt][r] : 0.f;
      }
      uint2 o; o.x = pack2(pv[0], pv[1]); o.y = pack2(pv[2], pv[3]);
      *(uint2*)(Ps + iq * 72 + jt * 16 + (lane >> 4) * 4) = o;
    }
    __syncthreads();
    __builtin_amdgcn_s_setprio(1);
#pragma unroll
    for (int ks = 0; ks < 2; ++ks) {
      const bf16x8 bq = frag(Qs, 16 * w, ks, lane);
      const bf16x8 bp = frag(Ps, 16 * w, ks, lane);
#pragma unroll
      for (int vt = 0; vt < 8; ++vt) {
        acc[vt] = mfma16(frag(ST, vt * 16, ks, lane), bq, acc[vt]);
        acc[vt] = mfma16(frag(VT, vt * 16, ks, lane), bp, acc[vt]);
      }
    }
    __builtin_amdgcn_s_setprio(0);
  }
  float ss = 0.f;
#pragma unroll
  for (int vt = 0; vt < 8; ++vt) ss += acc[vt][0] * acc[vt][0] + acc[vt][1] * acc[vt][1] + acc[vt][2] * acc[vt][2] + acc[vt][3] * acc[vt][3];
  ss += __shfl_xor(ss, 16); ss += __shfl_xor(ss, 32);
  const float rstd = __builtin_amdgcn_rsqf(ss * (1.f / 128.f) + 1e-6f);
  const int t = t0 + iq;
  const float* gn = p.in[18] + jl * 128;
#pragma unroll
  for (int vt = 0; vt < 8; ++vt) {
    const int v = vt * 16 + (lane >> 4) * 4;
    const uint2 graw = *(const uint2*)(PJ + (size_t)t * EV_IN + 1792 + h * 128 + v);
    const float4 g4 = *(const float4*)(gn + v);
    const float o0 = acc[vt][0] * rstd * g4.x * fsilu(bflo(graw.x));
    const float o1 = acc[vt][1] * rstd * g4.y * fsilu(bfhi(graw.x));
    const float o2 = acc[vt][2] * rstd * g4.z * fsilu(bflo(graw.y));
    const float o3 = acc[vt][3] * rstd * g4.w * fsilu(bfhi(graw.y));
    uint2 o; o.x = pack2(o0, o1); o.y = pack2(o2, o3);
    *(uint2*)(MIX + (size_t)t * 1024 + 512 + h * 128 + v) = o;
  }
}

__device__ __forceinline__ int sw_idx(int r, int c) { return r * 64 + ((((c >> 3) ^ (r >> 1)) & 7) << 3) + (c & 7); }
template <int PASS>
__device__ __forceinline__ void rg_item(const P& p, int item, int jl, char* lds) {
  bf16_t* XCb = (bf16_t*)lds;
  bf16_t* WT = XCb + 4096;
  float* As = (float*)(WT + 4 * 4096); float* Us = As + 64 * 65; float* segA = Us + 64 * 65; float* segU = segA + 256; float* bsm = segU + 256;
  const float* RGC = (const float*)(p.ws + WS_RGC);
  const float* CARRY = (const float*)(p.ws + WS_CARRY);
  const bf16_t* PJ2 = (const bf16_t*)(p.ws + WS_REGION);
  const bf16_t* WRG = (const bf16_t*)(p.ws + WS_WB) + WB_RG;
  float* AGG = (float*)(p.ws + WS_RGAGG);
  bf16_t* MIX = (bf16_t*)(p.ws + WS_H);
  const int tid = TID(), lane = tid & 63, w = tid >> 6;
  const int cgk = item >> 4, nb = item & 15;
  const int t0 = cgk * 64, ch0 = nb * 64;
  int s0, len; tok_seq(t0, s0, len);
  const int e_ = tid & 63, q = tid >> 6;
  const int ch = ch0 + e_;
  float xin[19];
  {
    const int tb = t0 + 16 * q - 2;
#pragma unroll
    for (int ii = 0; ii < 19; ++ii) { const int t = tb + ii; xin[ii] = (t >= s0 && t < s0 + len) ? bf2f(PJ2[(size_t)t * 2048 + 1024 + ch]) : 0.f; }
  }
  const float* cw = p.in[21] + jl * 4 * 1024 + ch;
  const float w0 = cw[0], w1 = cw[1024], w2 = cw[2048], w3 = cw[3072], cb = p.in[22][jl * 1024 + ch];
  const int wrow = tid >> 2, wsg = tid & 3;
  const bf16_t* wsrc = WRG + (size_t)nb * 4096 + wrow * 64 + wsg * 16;
  const uint4 wt00 = *(const uint4*)(wsrc), wt01 = *(const uint4*)(wsrc + 8);
  const uint4 wt10 = *(const uint4*)(wsrc + 16 * 4096), wt11 = *(const uint4*)(wsrc + 16 * 4096 + 8);
  const uint4 wt20 = *(const uint4*)(wsrc + 32 * 4096), wt21 = *(const uint4*)(wsrc + 32 * 4096 + 8);
  const uint4 wt30 = *(const uint4*)(wsrc + 48 * 4096), wt31 = *(const uint4*)(wsrc + 48 * 4096 + 8);
  float bs0 = 0.f, bs1 = 0.f;
  if (tid < 64) { bs0 = p.in[24][(jl * 2 + 0) * 1024 + ch0 + tid]; bs1 = p.in[24][(jl * 2 + 1) * 1024 + ch0 + tid]; }
  else if (tid < 128) { bs0 = p.in[26][(jl * 2 + 0) * 1024 + ch0 + tid - 64]; bs1 = p.in[26][(jl * 2 + 1) * 1024 + ch0 + tid - 64]; }
  else if (tid < 192) { bs0 = RGC[ch0 + tid - 128]; bs1 = RGC[1024 + ch0 + tid - 128]; }
  float cin0 = 0.f, cin1 = 0.f;
  if (PASS == 1) { cin0 = CARRY[(size_t)(cgk * 2 + 0) * 1024 + ch]; cin1 = CARRY[(size_t)(cgk * 2 + 1) * 1024 + ch]; }
  __syncthreads();
#pragma unroll
  for (int ii = 0; ii < 16; ++ii) {
    const float xc = cb + xin[ii] * w0 + xin[ii + 1] * w1 + xin[ii + 2] * w2 + xin[ii + 3] * w3;
    XCb[sw_idx(16 * q + ii, e_)] = f2bf(xc);
  }
  {
    const int s0_ = ((wsg * 2) ^ (wrow >> 1)) & 7, s1_ = ((wsg * 2 + 1) ^ (wrow >> 1)) & 7;
    bf16_t* d = WT + wrow * 64;
    *(uint4*)(d + s0_ * 8) = wt00; *(uint4*)(d + s1_ * 8) = wt01;
    *(uint4*)(d + 4096 + s0_ * 8) = wt10; *(uint4*)(d + 4096 + s1_ * 8) = wt11;
    *(uint4*)(d + 8192 + s0_ * 8) = wt20; *(uint4*)(d + 8192 + s1_ * 8) = wt21;
    *(uint4*)(d + 12288 + s0_ * 8) = wt30; *(uint4*)(d + 12288 + s1_ * 8) = wt31;
  }
  if (tid < 192) { bsm[tid] = bs0; bsm[192 + tid] = bs1; }
  float hsum[16];
#pragma unroll
  for (int ii = 0; ii < 16; ++ii) hsum[ii] = 0.f;
#pragma unroll
  for (int dir = 0; dir < 2; ++dir) {
    __syncthreads();
    const bf16_t* WTa = WT + (0 * 2 + dir) * 4096;
    const bf16_t* WTi = WT + (1 * 2 + dir) * 4096;
    const float* bs = bsm + dir * 192;
    f32x4 za[4], zi[4];
#pragma unroll
    for (int i = 0; i < 4; ++i) { za[i] = (f32x4){0.f, 0.f, 0.f, 0.f}; zi[i] = (f32x4){0.f, 0.f, 0.f, 0.f}; }
    __builtin_amdgcn_s_setprio(1);
#pragma unroll
    for (int ks = 0; ks < 2; ++ks) {
      const bf16x8 bx = frag_sw(XCb, 16 * w, ks, lane);
#pragma unroll
      for (int et = 0; et < 4; ++et) {
        za[et] = mfma16(frag_sw(WTa, et * 16, ks, lane), bx, za[et]);
        zi[et] = mfma16(frag_sw(WTi, et * 16, ks, lane), bx, zi[et]);
      }
    }
    __builtin_amdgcn_s_setprio(0);
    {
      const int i = 16 * w + (lane & 15);
#pragma unroll
      for (int et = 0; et < 4; ++et)
#pragma unroll
        for (int rp = 0; rp < 2; ++rp) {
          const int e = et * 16 + (lane >> 4) * 4 + 2 * rp;
          const f32x2_t zA = (f32x2_t){za[et][2 * rp], za[et][2 * rp + 1]} + (f32x2_t){bs[e], bs[e + 1]};
          const f32x2_t zI = (f32x2_t){zi[et][2 * rp], zi[et][2 * rp + 1]} + (f32x2_t){bs[64 + e], bs[64 + e + 1]};
          f32x2_t xa = zA * (-LOG2E), xi = zI * (-LOG2E);
          xa.x = fminf(xa.x, 60.f); xa.y = fminf(xa.y, 60.f); xi.x = fminf(xi.x, 60.f); xi.y = fminf(xi.y, 60.f);
          const f32x2_t ea = (f32x2_t){__builtin_amdgcn_exp2f(xa.x), __builtin_amdgcn_exp2f(xa.y)};
          const f32x2_t ei = (f32x2_t){__builtin_amdgcn_exp2f(xi.x), __builtin_amdgcn_exp2f(xi.y)};
          const f32x2_t pa = ea + 1.f, pi = ei + 1.f;
          const f32x2_t pp = pa * pi;
          const f32x2_t R = (f32x2_t){frcp(pp.x), frcp(pp.y)};
          const f32x2_t rr = pi * R, ig = pa * R;
          const f32x2_t la = rr * (f32x2_t){bs[128 + e], bs[128 + e + 1]};
          const f32x2_t t = la * (la * (la * (la * (la * 0.0083333338f + 0.041666668f) + 0.16666667f) + 0.5f) + 1.f);
          const f32x2_t em = -t * (t + 2.f);
          const unsigned int xraw = *(const unsigned int*)(XCb + sw_idx(i, e));
          const f32x2_t xc = (f32x2_t){bflo(xraw), bfhi(xraw)};
          const f32x2_t sq = (f32x2_t){__builtin_amdgcn_sqrtf(em.x), __builtin_amdgcn_sqrtf(em.y)};
          const f32x2_t av = t + 1.f, uv = sq * ig * xc;
          As[i * 65 + e] = av.x; As[i * 65 + e + 1] = av.y;
          Us[i * 65 + e] = uv.x; Us[i * 65 + e + 1] = uv.y;
        }
    }
    __syncthreads();
    float Ap = 1.f, Ua = 0.f;
    if (dir == 0) {
#pragma unroll
      for (int ii = 0; ii < 16; ++ii) { const float a = As[(16 * q + ii) * 65 + e_], u = Us[(16 * q + ii) * 65 + e_]; Ua = a * Ua + u; Ap *= a; }
    } else {
#pragma unroll
      for (int ii = 15; ii >= 0; --ii) { const float a = As[(16 * q + ii) * 65 + e_], u = Us[(16 * q + ii) * 65 + e_]; Ua = a * Ua + u; Ap *= a; }
    }
    segA[q * 64 + e_] = Ap; segU[q * 64 + e_] = Ua;
    __syncthreads();
    if (PASS == 0) {
      if (q == 0) {
        float A = 1.f, U = 0.f;
        if (dir == 0) { for (int s = 0; s < 4; ++s) { const float a = segA[s * 64 + e_], u = segU[s * 64 + e_]; U = a * U + u; A *= a; } }
        else { for (int s = 3; s >= 0; --s) { const float a = segA[s * 64 + e_], u = segU[s * 64 + e_]; U = a * U + u; A *= a; } }
        AGG[((size_t)(cgk * 2 + dir) * 2 + 0) * 1024 + ch] = A;
        AGG[((size_t)(cgk * 2 + dir) * 2 + 1) * 1024 + ch] = U;
      }
    } else {
      float hc = dir == 0 ? cin0 : cin1;
      if (dir == 0) {
        for (int s = 0; s < q; ++s) hc = segA[s * 64 + e_] * hc + segU[s * 64 + e_];
#pragma unroll
        for (int ii = 0; ii < 16; ++ii) { hc = As[(16 * q + ii) * 65 + e_] * hc + Us[(16 * q + ii) * 65 + e_]; hsum[ii] += hc; }
      } else {
        for (int s = 3; s > q; --s) hc = segA[s * 64 + e_] * hc + segU[s * 64 + e_];
#pragma unroll
        for (int ii = 15; ii >= 0; --ii) { hc = As[(16 * q + ii) * 65 + e_] * hc + Us[(16 * q + ii) * 65 + e_]; hsum[ii] += hc; }
      }
    }
  }
  if (PASS == 1) {
#pragma unroll
    for (int ii = 0; ii < 16; ++ii) {
      const int t = t0 + 16 * q + ii;
      const float gy = bf2f(PJ2[(size_t)t * 2048 + ch]);
      MIX[(size_t)t * 1024 + ch] = f2bf(gy * hsum[ii]);
    }
  }
}

__device__ __forceinline__ void rg_carry(const P& p, int jl) {
  const float* AGG = (const float*)(p.ws + WS_RGAGG);
  float* CARRY = (float*)(p.ws + WS_CARRY);
  for (int idx = BID() * 256 + TID(); idx < 36 * 2048; idx += gridDim.x * 256) {
    const int ch = idx & 1023, dir = (idx >> 10) & 1, sx = idx >> 11;
    const bool sample = sx < 4;
    const int sq = sample ? sx : sx - 4;
    const int chunk0 = sample ? 128 + sq * 64 : sq * 4;
    const int nch = sample ? 64 : 4;
    float h = sample ? p.in[5][((sq * 2 + jl) * 2 + dir) * 1024 + ch] : 0.f;
    for (int base = 0; base < nch; base += 4) {
      float A[4], U[4]; int cc[4];
#pragma unroll
      for (int k = 0; k < 4; ++k) {
        cc[k] = dir == 0 ? chunk0 + base + k : chunk0 + nch - 1 - (base + k);
        A[k] = AGG[((size_t)(cc[k] * 2 + dir) * 2 + 0) * 1024 + ch];
        U[k] = AGG[((size_t)(cc[k] * 2 + dir) * 2 + 1) * 1024 + ch];
      }
#pragma unroll
      for (int k = 0; k < 4; ++k) { CARRY[(size_t)(cc[k] * 2 + dir) * 1024 + ch] = h; h = A[k] * h + U[k]; }
    }
    if (!sample) p.out[OUT_RG + ((sq * 2 + jl) * 2 + dir) * 1024 + ch] = h;
  }
}

#define XB_TMO      128
#define XB_XCNT(j)  (256  + 64 * (j))
#define XB_XSUB(j)  (1280 + 64 * (j))
#define XB_XGEN(j)  (2304 + 64 * (j))
#define XB_TOP      3328
#define XB_TOPGEN   3392
#define XCD_BAR_WORDS 3456
#define XB_SPIN_CAP (1u << 22)
__device__ __forceinline__ unsigned xb_ld(unsigned* p)              { return __hip_atomic_load(p, __ATOMIC_RELAXED, __HIP_MEMORY_SCOPE_AGENT); }
__device__ __forceinline__ unsigned xb_add(unsigned* p, unsigned v) { return __hip_atomic_fetch_add(p, v, __ATOMIC_RELAXED, __HIP_MEMORY_SCOPE_AGENT); }
__device__ __forceinline__ unsigned xb_xcc_id() { return (unsigned)__builtin_amdgcn_s_getreg((3 << 11) | 20) & 0xFu; }
#define XB_SPIN(cond, bar) do { unsigned _sp = 0; while (cond) { __builtin_amdgcn_s_sleep(1); \
    if ((++_sp & 255u) == 0u) { if (xb_ld(&(bar)[XB_TMO])) break; if (_sp > XB_SPIN_CAP) { atomicAdd(&(bar)[XB_TMO], 1u); break; } } } } while (0)
struct XcdBarrier { unsigned* bar; unsigned x; volatile unsigned* st; };
__device__ __forceinline__ XcdBarrier xcd_barrier_post(unsigned* bar, volatile unsigned* st) {
  XcdBarrier b; b.bar = bar; b.x = xb_xcc_id(); b.st = st;
  if (threadIdx.x == 0) (void)xb_add(&bar[XB_XCNT(b.x)], 1u);
  return b;
}
__device__ __forceinline__ void xcd_barrier_complete(unsigned* bar, unsigned x, unsigned& nloc, unsigned& nx) {
  const unsigned G = gridDim.x * gridDim.y * gridDim.z;
  unsigned sum, cnt, mine, sp = 0u;
  for (;;) {
    sum = 0u; cnt = 0u; mine = 0u;
#pragma unroll
    for (unsigned j = 0; j < 16; ++j) { const unsigned c = xb_ld(&bar[XB_XCNT(j)]); sum += c; cnt += (c > 0u) ? 1u : 0u; mine = (j == x) ? c : mine; }
    if (sum == G) break;
    __builtin_amdgcn_s_sleep(1);
    if ((++sp & 255u) == 0u) { if (xb_ld(&bar[XB_TMO])) break; if (sp > XB_SPIN_CAP) { atomicAdd(&bar[XB_TMO], 1u); break; } }
  }
  nloc = mine > 0u ? mine : 1u; nx = cnt > 0u ? cnt : 1u;
}
__device__ __forceinline__ void xcd_barrier(const XcdBarrier& b) {
  asm volatile("s_waitcnt vmcnt(0)" ::: "memory");
  __syncthreads();
  if (threadIdx.x == 0) {
    unsigned* bar = b.bar;
    __builtin_amdgcn_s_waitcnt(0);
    unsigned nloc = b.st[0], nx = b.st[1];
    if (nloc == 0u) { xcd_barrier_complete(bar, b.x, nloc, nx); b.st[0] = nloc; b.st[1] = nx; }
    const unsigned old = xb_add(&bar[XB_XSUB(b.x)], 1u);
    const unsigned gen = old / nloc;
    if (old + 1u == (gen + 1u) * nloc) {
      __builtin_amdgcn_fence(__ATOMIC_RELEASE, "agent");
      asm volatile("s_waitcnt vmcnt(0)" ::: "memory");
      const unsigned og = xb_add(&bar[XB_TOP], 1u);
      const unsigned tg = og / nx;
      if (og + 1u == (tg + 1u) * nx) xb_add(&bar[XB_TOPGEN], 1u);
      else XB_SPIN(xb_ld(&bar[XB_TOPGEN]) == tg, bar);
      __builtin_amdgcn_fence(__ATOMIC_ACQUIRE, "agent");
      xb_add(&bar[XB_XGEN(b.x)], 1u);
      asm volatile("s_waitcnt vmcnt(0)" ::: "memory");
    } else {
      XB_SPIN(xb_ld(&bar[XB_XGEN(b.x)]) == gen, bar);
      __builtin_amdgcn_fence(__ATOMIC_ACQUIRE, "agent");
      asm volatile("s_waitcnt vmcnt(0)" ::: "memory");
    }
  }
  __syncthreads();
}

__device__ __forceinline__ void run_phase(const P& p, int ph, char* lds) {
  if (ph == 0) { if (EN(0)) phase0(p, lds); if (PB(6)) phase0(p, lds); return; }
  if (ph == NPH - 1) { if (EN(13)) final_norm(p); return; }
  int q = ph - 1, layer = 0;
  for (; layer < 4; ++layer) { if (q < 10) break; q -= 10; }
  const bool even = (layer & 1) == 0;
  const int jl = layer >> 1;
  const int nmix = 6;
  const float* mod_l = (const float*)(p.ws + WS_MOD) + layer * 5 * 6144;
  bf16_t* WB = (bf16_t*)(p.ws + WS_WB);
  bf16_t* H = (bf16_t*)(p.ws + WS_H);
  bf16_t* REG = (bf16_t*)(p.ws + WS_REGION);
  GemmArgs g;
  g.m_off = 0; g.o16 = REG; g.X = p.out; g.gate = mod_l; g.outk = p.out + OUT_K; g.outv = p.out + OUT_V; g.jl = jl; g.dry = 0; g.cw = nullptr; g.cb = nullptr; g.halo = nullptr; g.x0p = nullptr; g.x0s = nullptr; g.qctr = (unsigned*)(p.ws + WS_QCTR) + ph * 128;
  if (q == 0) {
    if (EN(1)) convert_weights(p, layer, lds);
    if (EN(1)) norm_rows(p, p.in[8] + layer * 1024, mod_l, 0, layer == 0);
    if (PB(6)) { convert_weights(p, layer, lds); norm_rows(p, p.in[8] + layer * 1024, mod_l, 0, layer == 0); }
    if (!even) {
      float* RGC = (float*)(p.ws + WS_RGC);
      for (int idx = BID() * 256 + TID(); idx < 2048; idx += gridDim.x * 256) RGC[idx] = 8.f * logsigf_(p.in[27][jl * 2048 + idx]);
    }
    return;
  }
  if (q == 1) {
    g.A = H; g.lda = 1024; g.Bt = WB + WB_IN; g.K = 1024; g.M = T_ALL;
    if (even) { g.NP = EV_INP; if (EN(2)) gemm_phase<0>(g, lds); } else { g.NP = 2048; if (EN(3)) gemm_phase<1>(g, lds); }
#if PROBE_GEMM2
    if (even) { gemm_phase<0>(g, lds); } else { gemm_phase<1>(g, lds); }
#endif
    return;
  }
  if (q == nmix - 1) {
    g.A = H; g.lda = 1024; g.Bt = WB + WB_OUT; g.K = 1024; g.M = T_ALL; g.NP = 1024; g.gate = mod_l + 2 * 1024;
    if (layer == 0) { g.x0p = p.in[0]; g.x0s = p.in[1]; }
    if (EN(4)) gemm_phase<2>(g, lds);
#if PROBE_GEMM2
    g.dry = p.pad + 1; gemm_phase<2>(g, lds);
#endif
    return;
  }
  if (q < nmix) {
    if (even) {
      if (q == 2) {
        for (int it = BID(); it < 1536; it += gridDim.x) { if (EN(6)) gla_pass1_item(p, it, jl, lds); if (PB(2)) gla_pass1_item(p, it, jl, lds); }
      } else if (q == 3) {
        attn_stage_rope(p, lds);
        for (int it = BID(); it < 2304 + 1536; it += gridDim.x) {
          if (it < 2304) { if (EN(7)) gla_pass2_item(p, it, jl); if (PB(8)) gla_pass2_item(p, it, jl, p.pad + 1); }
          else { if (EN(5)) attn_item(p, it - 2304, jl, lds); if (PB(1)) attn_item(p, it - 2304, jl, lds); }
        }
      } else {
        for (int it = BID(); it < 1536; it += gridDim.x) { if (EN(8)) gla_pass3_item(p, it, jl, lds); if (PB(3)) gla_pass3_item(p, it, jl, lds); }
      }
    } else {
      if (q == 2) { for (int it = BID(); it < 6144; it += gridDim.x) { if (EN(9)) rg_item<0>(p, it, jl, lds); if (PB(4)) rg_item<0>(p, it, jl, lds); } }
      else if (q == 3) { rg_carry(p, jl); if (PB(9)) rg_carry(p, jl); }
      else { for (int it = BID(); it < 6144; it += gridDim.x) { if (EN(10)) rg_item<1>(p, it, jl, lds); if (PB(4)) rg_item<1>(p, it, jl, lds); } }
    }
    return;
  }
  const int f = q - nmix;
  if (f == 0) { if (EN(1)) norm_rows(p, p.in[9] + layer * 1024, mod_l, 3, false); return; }
  if (f == 1) {
    g.A = H; g.lda = 1024; g.Bt = WB + WB_UP; g.K = 1024; g.M = T_ALL; g.NP = DFF2;
    g.cw = p.in[30] + (size_t)layer * 3 * DFF2; g.cb = p.in[31] + (size_t)layer * DFF2; g.halo = (float*)(p.ws + WS_STATES);
    if (EN(12)) gemm_phase<3>(g, lds);
#if PROBE_GEMM2
    gemm_phase<3>(g, lds);
#endif
  } else if (f == 2) {
    if (EN(11)) ffn_fixup(p, layer);
    if (PB(10)) ffn_fixup(p, layer);
  } else {
    g.A = REG; g.lda = DFF; g.Bt = WB + WB_DOWN; g.K = DFF; g.M = T_ALL; g.NP = 1024;
    g.m_off = 0; g.gate = mod_l + 5 * 1024;
    if (EN(4)) gemm_phase<2>(g, lds);
#if PROBE_GEMM2
    g.dry = p.pad + 1; gemm_phase<2>(g, lds);
#endif
  }
}

__global__ void __launch_bounds__(256, 2) mega(P p) {
  extern __shared__ __attribute__((aligned(16))) char lds_raw[];
  char* lds = lds_raw + 16;
  XcdBarrier xb;
  if (p.coop) {
    volatile unsigned* st = (volatile unsigned*)lds_raw;
    if (threadIdx.x == 0) { st[0] = 0u; st[1] = 0u; st[2] = 0u; st[3] = 0u; }
    __syncthreads();
    xb = xcd_barrier_post((unsigned*)(p.ws + WS_BAR), st);
  }
  for (int ph = p.ph_lo; ph < p.ph_hi; ++ph) {
    run_phase(p, ph, lds);
    if (p.coop && ph + 1 < p.ph_hi) {
      if (ph == p.ph_lo) cg::this_grid().sync();
      else { xcd_barrier(xb); if (PB(7)) xcd_barrier(xb); }
    }
  }
}

extern "C" void kernel_launch(void* const* d_in, const int* in_sizes, int n_in, void* d_out, int out_size, void* d_ws, size_t ws_size,
                              hipStream_t stream) {
  static int grid = 0;
  if (!grid) {
    int dev = 0, cus = 0, per_cu = 0;
    (void)hipGetDevice(&dev);
    (void)hipDeviceGetAttribute(&cus, hipDeviceAttributeMultiprocessorCount, dev);
    (void)hipFuncSetAttribute((const void*)mega, hipFuncAttributeMaxDynamicSharedMemorySize, LDS_BYTES);
    (void)hipOccupancyMaxActiveBlocksPerMultiprocessor(&per_cu, (const void*)mega, 256, LDS_BYTES);
    if (per_cu < 1) per_cu = 1;
    if (per_cu > 2) per_cu = 2;
    grid = cus * per_cu;
    if (ws_size < WS_END) fprintf(stderr, "kernel_launch: workspace too small: %zu < %llu\n", ws_size, (unsigned long long)WS_END);
  }
  P p;
  memset(&p, 0, sizeof(p));
  for (int i = 0; i < 34; ++i) p.in[i] = (const float*)d_in[i];
  p.out = (float*)d_out; p.ws = (unsigned char*)d_ws;
#if COOP
  (void)hipMemsetAsync((char*)d_ws + WS_BAR, 0, 16384 + 32768, stream);
  p.ph_lo = 0; p.ph_hi = NPH; p.coop = 1;
  void* args[] = {&p};
  hipError_t e = hipLaunchCooperativeKernel((const void*)mega, dim3(grid), dim3(256), args, LDS_BYTES, stream);
  if (e != hipSuccess) fprintf(stderr, "cooperative launch failed: %s (grid %d)\n", hipGetErrorString(e), grid);
#else
  for (int ph = 0; ph < NPH; ++ph) {
    p.ph_lo = ph; p.ph_hi = ph + 1; p.coop = 0;
    hipLaunchKernelGGL(mega, dim3(grid), dim3(256), LDS_BYTES, stream, p);
  }
#endif
}
```

```cpp
#include <hip/hip_runtime.h>
#include <hip/hip_cooperative_groups.h>
#include <cstdio>
#include <cstdint>
#include <cstring>
namespace cg = cooperative_groups;

#ifndef COOP
#define COOP 1
#endif
#ifndef PROBE_GEMM2
#define PROBE_GEMM2 0
#endif
#ifndef PROBE
#define PROBE 0
#endif
#define PB(b) ((PROBE >> (b)) & 1)
#ifndef ONLYP
#define ONLYP -1
#endif
#define EN(x) (ONLYP < 0 || ONLYP == (x))

typedef unsigned short bf16_t;
#define LAS __attribute__((address_space(3)))
using bf16x8 = __attribute__((ext_vector_type(8))) short;
using f32x4 = __attribute__((ext_vector_type(4))) float;

#define T_ALL 24576
#define T_PROMPT 8192
#define DM 1024
#define EV_IN 2336
#define EV_INP 2432
#define DFF 2816
#define DFF2 5632
#define NPH 42
#define LDS_BYTES 77840
#define LOG2E 1.4426950408889634f

#define OUT_K 25165824
#define OUT_V 27262976
#define OUT_GLA 29360128
#define OUT_RG 33554432

#define WS_MOD 4096ull
#define WS_ROPE (WS_MOD + 491520ull)
#define WS_RGAGG (WS_ROPE + 8192ull)
#define WS_GLA_A (WS_RGAGG + 6291456ull)
#define WS_WB (WS_GLA_A + 786432ull)
#define WS_H (WS_WB + 24903680ull)
#define WS_REGION (WS_H + 50331648ull)
#define WS_STATES (WS_REGION + 138412032ull)
#define WS_BAR (WS_STATES + 100663296ull)
#define WS_QCTR (WS_BAR + 16384ull)
#define WS_RGC (WS_QCTR + 32768ull)
#define WS_CARRY (WS_RGC + 8192ull)
#define WS_END (WS_CARRY + 3145728ull)

#define WB_IN 0
#define WB_OUT 2490368
#define WB_UP (WB_OUT + 1048576)
#define WB_DOWN (WB_UP + 5767168)
#define WB_RG (WB_DOWN + 2883584)

struct P {
  const float* in[34];
  float* out;
  unsigned char* ws;
  int ph_lo, ph_hi, coop, pad;
};

__device__ __forceinline__ int TID() { int t = threadIdx.x; asm volatile("" : "+v"(t)); return t; }
__device__ __forceinline__ int BID() { int b = blockIdx.x; asm volatile("" : "+s"(b)); return b; }
typedef __bf16 bf16x2_t __attribute__((ext_vector_type(2)));
typedef float f32x2_t __attribute__((ext_vector_type(2)));
__device__ __forceinline__ unsigned int pack2(float a, float b) { f32x2_t v = {a, b}; bf16x2_t r = __builtin_convertvector(v, bf16x2_t); return __builtin_bit_cast(unsigned int, r); }
__device__ __forceinline__ unsigned short f2bf(float f) { return (unsigned short)(pack2(f, 0.f) & 0xffffu); }
__device__ __forceinline__ float bf2f(unsigned short h) { return __uint_as_float(((unsigned int)h) << 16); }
__device__ __forceinline__ float bflo(unsigned int u) { return __uint_as_float(u << 16); }
__device__ __forceinline__ float bfhi(unsigned int u) { return __uint_as_float(u & 0xffff0000u); }
__device__ __forceinline__ void unpack8(uint4 r, float* x) {
  x[0] = bflo(r.x); x[1] = bfhi(r.x); x[2] = bflo(r.y); x[3] = bfhi(r.y);
  x[4] = bflo(r.z); x[5] = bfhi(r.z); x[6] = bflo(r.w); x[7] = bfhi(r.w);
}
__device__ __forceinline__ uint4 pack8(const float* x) {
  uint4 r; r.x = pack2(x[0], x[1]); r.y = pack2(x[2], x[3]); r.z = pack2(x[4], x[5]); r.w = pack2(x[6], x[7]); return r;
}
__device__ __forceinline__ float wave_sum(float v) {
#pragma unroll
  for (int o = 1; o < 64; o <<= 1) v += __shfl_xor(v, o);
  return v;
}
__device__ __forceinline__ float sigmoidf_(float x) { return 1.f / (1.f + expf(-x)); }
__device__ __forceinline__ float siluf_(float x) { return x / (1.f + expf(-x)); }
__device__ __forceinline__ float logsigf_(float z) { return fminf(z, 0.f) - log1pf(expf(-fabsf(z))); }
__device__ __forceinline__ float frcp(float x) { return __builtin_amdgcn_rcpf(x); }
__device__ __forceinline__ float fsigmoid(float x) { return frcp(1.f + __expf(-x)); }
__device__ __forceinline__ float fsilu(float x) { return x * fsigmoid(x); }
__device__ __forceinline__ float flogsig(float z) { return fminf(z, 0.f) - 0.6931471806f * __builtin_amdgcn_logf(1.f + __builtin_amdgcn_exp2f(-fabsf(z) * LOG2E)); }
__device__ __forceinline__ float gelu_tanh(float x) {
  const float z2 = 1.5957691216057308f * (x + 0.044715f * x * x * x);
  return x * __builtin_amdgcn_rcpf(1.f + __builtin_amdgcn_exp2f(-z2 * LOG2E));
}
__device__ __forceinline__ int tok_cond(int t) { return t < T_PROMPT ? 0 : 1 + ((t - T_PROMPT) >> 12); }
__device__ __forceinline__ void tok_seq(int t, int& s0, int& len) {
  if (t < T_PROMPT) { s0 = t & ~255; len = 256; } else { s0 = T_PROMPT + (((t - T_PROMPT) >> 12) << 12); len = 4096; }
}
__device__ __forceinline__ f32x4 mfma16(bf16x8 a, bf16x8 b, f32x4 c) { return __builtin_amdgcn_mfma_f32_16x16x32_bf16(a, b, c, 0, 0, 0); }
__device__ __forceinline__ bf16x8 frag(const bf16_t* s, int row0, int ks, int lane) {
  return *(const bf16x8*)(s + (row0 + (lane & 15)) * 72 + ks * 32 + (lane >> 4) * 8);
}

__device__ __forceinline__ bf16x8 frag_sw(const bf16_t* s, int row0, int ks, int lane) {
  const int kc = (ks * 4 + (lane >> 4)) ^ ((lane >> 1) & 7);
  return *(const bf16x8*)(s + (row0 + (lane & 15)) * 64 + kc * 8);
}

__device__ __forceinline__ void phase0(const P& p, char* lds) {
  const int tid = TID();
  if (BID() == 0) {
    float* rope = (float*)(p.ws + WS_ROPE);
    for (int e = tid; e < 1024; e += 256) {
      int pos = e >> 4, f = e & 15;
      float inv = powf(10000.f, -(float)f / 16.f);
      float ang = (float)pos * inv;
      rope[e * 2] = cosf(ang); rope[e * 2 + 1] = sinf(ang);
    }
  }
  float* sc = (float*)lds;
  float* red = sc + 5120;
  float* MOD = (float*)(p.ws + WS_MOD);
  bool loaded = false;
  for (int it = BID(); it < 384; it += gridDim.x) {
    if (!loaded) {
      for (int e = tid; e < 5120; e += 256) {
        int c = e >> 10, k = e & 1023;
        float v = (c == 0) ? p.in[7][k] : p.in[6][(c - 1) * 1024 + k];
        sc[e] = siluf_(v);
      }
      __syncthreads();
      loaded = true;
    }
    const int l = it / 96, c0 = (it % 96) * 64;
    const int col = c0 + (tid & 63), kg = tid >> 6;
    const float* W = p.in[10] + (size_t)l * 1024 * 6144 + col;
    float acc[5] = {0.f, 0.f, 0.f, 0.f, 0.f};
#pragma unroll 16
    for (int k = kg * 256; k < kg * 256 + 256; ++k) {
      float wv = W[(size_t)k * 6144];
#pragma unroll
      for (int c = 0; c < 5; ++c) acc[c] += sc[c * 1024 + k] * wv;
    }
#pragma unroll
    for (int c = 0; c < 5; ++c) red[(kg * 5 + c) * 64 + (tid & 63)] = acc[c];
    __syncthreads();
    for (int e = tid; e < 320; e += 256) {
      int c = e >> 6, cc = e & 63;
      float s = red[(0 * 5 + c) * 64 + cc] + red[(1 * 5 + c) * 64 + cc] + red[(2 * 5 + c) * 64 + cc] + red[(3 * 5 + c) * 64 + cc];
      MOD[(l * 5 + c) * 6144 + c0 + cc] = s + p.in[11][l * 6144 + c0 + cc];
    }
    __syncthreads();
  }
}

__device__ __forceinline__ void transpose_item(const float* W, int K, int N, bf16_t* WT, int item, char* lds, bool remap = false) {
  float* tile = (float*)lds;
  const int tid = TID();
  const int nblk = N >> 5, kb = item / nblk, nbk = item - kb * nblk, k0 = kb * 64, n0 = nbk * 32;
  __syncthreads();
  {
    const int kr = tid >> 3, c4 = (tid & 7) * 4;
#pragma unroll
    for (int ps = 0; ps < 2; ++ps) {
      float4 v = *(const float4*)(W + (size_t)(k0 + kr + 32 * ps) * N + n0 + c4);
      float* d = tile + (kr + 32 * ps) * 33 + c4;
      d[0] = v.x; d[1] = v.y; d[2] = v.z; d[3] = v.w;
    }
  }
  __syncthreads();
  {
    const int n = tid >> 3, kc = (tid & 7) * 8;
    float x[8];
#pragma unroll
    for (int e = 0; e < 8; ++e) x[e] = tile[(kc + e) * 33 + n];
    const int r0 = remap ? (((n0 % DFF) >> 6) * 128 + (n0 >= DFF ? 64 : 0) + (n0 & 63)) : n0;
    *(uint4*)(WT + (size_t)(r0 + n) * K + k0 + kc) = pack8(x);
  }
}

__device__ __forceinline__ void convert_weights(const P& p, int layer, char* lds) {
  bf16_t* WB = (bf16_t*)(p.ws + WS_WB);
  const int jl = layer >> 1;
  const bool even = (layer & 1) == 0;
  const int n_in = even ? 16 * 73 : 16 * 64;
  const int n_out = 16 * 32, n_up = 16 * 176, n_down = 44 * 32;
  const int n_extra = even ? 96 : 128;
  const int total = n_in + n_out + n_up + n_down + n_extra;
  for (int it = BID(); it < total; it += gridDim.x) {
    int r = it;
    if (r < n_in) {
      if (even) transpose_item(p.in[12] + (size_t)jl * 1024 * EV_IN, 1024, EV_IN, WB + WB_IN, r, lds);
      else transpose_item(p.in[20] + (size_t)jl * 1024 * 2048, 1024, 2048, WB + WB_IN, r, lds);
      continue;
    }
    r -= n_in;
    if (r < n_out) {
      transpose_item((even ? p.in[19] : p.in[28]) + (size_t)jl * 1024 * 1024, 1024, 1024, WB + WB_OUT, r, lds);
      continue;
    }
    r -= n_out;
    if (r < n_up) { transpose_item(p.in[29] + (size_t)layer * 1024 * DFF2, 1024, DFF2, WB + WB_UP, r, lds, true); continue; }
    r -= n_up;
    if (r < n_down) { transpose_item(p.in[32] + (size_t)layer * DFF * 1024, DFF, 1024, WB + WB_DOWN, r, lds); continue; }
    r -= n_down;
    if (even) {
      uint2 z; z.x = 0; z.y = 0;
      *(uint2*)(WB + WB_IN + (size_t)(EV_IN + r) * 1024 + TID() * 4) = z;
    } else {
      const int mi = r >> 1, sub = r & 1;
      const int g = mi >> 5, dir = (mi >> 4) & 1, nb = mi & 15;
      const float* src = (g == 0 ? p.in[23] : p.in[25]) + ((size_t)((jl * 2 + dir) * 16 + nb)) * 4096;
      transpose_item(src, 64, 64, WB + WB_RG + (size_t)mi * 4096, sub, lds);
    }
  }
}

__device__ __forceinline__ const float* x_row(const P& p, bool from_inputs, int row) {
  return from_inputs ? (row < T_PROMPT ? p.in[0] + (size_t)row * 1024 : p.in[1] + (size_t)(row - T_PROMPT) * 1024) : p.out + (size_t)row * 1024;
}
__device__ __forceinline__ void norm_rows(const P& p, const float* g, const float* mod_l, int shift_idx, bool from_inputs) {
  const int tid = TID(), lane = tid & 63, wave = tid >> 6;
  bf16_t* H = (bf16_t*)(p.ws + WS_H);
  for (int row0 = (BID() * 4 + wave) * 2; row0 < T_ALL; row0 += gridDim.x * 8) {
    float4 v[2][4]; float ss[2];
#pragma unroll
    for (int r = 0; r < 2; ++r) {
      const float4* xr = (const float4*)x_row(p, from_inputs, row0 + r);
      ss[r] = 0.f;
#pragma unroll
      for (int j = 0; j < 4; ++j) { v[r][j] = xr[lane + 64 * j]; }
    }
#pragma unroll
    for (int r = 0; r < 2; ++r) {
#pragma unroll
      for (int j = 0; j < 4; ++j) ss[r] += v[r][j].x * v[r][j].x + v[r][j].y * v[r][j].y + v[r][j].z * v[r][j].z + v[r][j].w * v[r][j].w;
      ss[r] = wave_sum(ss[r]);
    }
#pragma unroll
    for (int r = 0; r < 2; ++r) {
      const int row = row0 + r;
      const float rstd = __builtin_amdgcn_rsqf(ss[r] * (1.f / 1024.f) + 1e-6f);
      const int cond = tok_cond(row);
      const float* sh = mod_l + cond * 6144 + shift_idx * 1024;
      const float* scl = sh + 1024;
#pragma unroll
      for (int j = 0; j < 4; ++j) {
        const int k = (lane + 64 * j) * 4;
        const float4 g4 = *(const float4*)(g + k), s4 = *(const float4*)(scl + k), h4 = *(const float4*)(sh + k);
        float o0 = v[r][j].x * rstd * g4.x * (1.f + s4.x) + h4.x;
        float o1 = v[r][j].y * rstd * g4.y * (1.f + s4.y) + h4.y;
        float o2 = v[r][j].z * rstd * g4.z * (1.f + s4.z) + h4.z;
        float o3 = v[r][j].w * rstd * g4.w * (1.f + s4.w) + h4.w;
        uint2 o; o.x = pack2(o0, o1); o.y = pack2(o2, o3);
        *(uint2*)(H + (size_t)row * 1024 + k) = o;
      }
    }
  }
}

__device__ __forceinline__ void final_norm(const P& p) {
  const int tid = TID(), lane = tid & 63, wave = tid >> 6;
  float* X = p.out;
  const float* g = p.in[33];
  for (int row = BID() * 4 + wave; row < T_ALL; row += gridDim.x * 4) {
    float4* xr = (float4*)(X + (size_t)row * 1024);
    float4 v[4]; float ss = 0.f;
#pragma unroll
    for (int j = 0; j < 4; ++j) { v[j] = xr[lane + 64 * j]; ss += v[j].x * v[j].x + v[j].y * v[j].y + v[j].z * v[j].z + v[j].w * v[j].w; }
    ss = wave_sum(ss);
    const float rstd = 1.f / sqrtf(ss * (1.f / 1024.f) + 1e-6f);
#pragma unroll
    for (int j = 0; j < 4; ++j) {
      const float4 g4 = *(const float4*)(g + (lane + 64 * j) * 4);
      float4 o; o.x = v[j].x * rstd * g4.x; o.y = v[j].y * rstd * g4.y; o.z = v[j].z * rstd * g4.z; o.w = v[j].w * rstd * g4.w;
      xr[lane + 64 * j] = o;
    }
  }
}

struct GemmArgs {
  const bf16_t* A; int lda; const bf16_t* Bt; int K; int M; int NP;
  int m_off;
  bf16_t* o16;
  float* X;
  const float* gate;
  float* outk; float* outv; int jl; int dry;
  const float* cw; const float* cb; float* halo;
  const float* x0p; const float* x0s;
  unsigned* qctr;
};

template <int EPI>
__device__ __forceinline__ void gemm_epi(const GemmArgs& g, int m, int n, f32x4 a) {
  if (EPI == 0) {
    if (n < EV_IN) {
      uint2 o; o.x = pack2(a[0], a[1]); o.y = pack2(a[2], a[3]);
      *(uint2*)(g.o16 + (size_t)m * EV_IN + n) = o;
      if (m < T_PROMPT && n >= 512 && n < 768) {
        const int b = m >> 8, s = m & 255;
        float4 f; f.x = a[0]; f.y = a[1]; f.z = a[2]; f.w = a[3];
        if (n < 640) *(float4*)(g.outk + ((size_t)((b * 2 + g.jl) * 256 + s)) * 128 + (n - 512)) = f;
        else *(float4*)(g.outv + ((size_t)((b * 2 + g.jl) * 256 + s)) * 128 + (n - 640)) = f;
      }
    }
  } else if (EPI == 1) {
    float v0 = a[0], v1 = a[1], v2 = a[2], v3 = a[3];
    if (n < 1024) { v0 = gelu_tanh(v0); v1 = gelu_tanh(v1); v2 = gelu_tanh(v2); v3 = gelu_tanh(v3); }
    uint2 o; o.x = pack2(v0, v1); o.y = pack2(v2, v3);
    *(uint2*)(g.o16 + (size_t)m * 2048 + n) = o;
  } else if (EPI == 2) {
    const int t = g.m_off + m;
    const float4 gt = *(const float4*)(g.gate + tok_cond(t) * 6144 + n);
    float4* xp = (float4*)(g.X + (size_t)t * 1024 + n);
    float4 x = g.x0p ? (t < T_PROMPT ? *(const float4*)(g.x0p + (size_t)t * 1024 + n) : *(const float4*)(g.x0s + (size_t)(t - T_PROMPT) * 1024 + n)) : *xp;
    x.x += gt.x * a[0]; x.y += gt.y * a[1]; x.z += gt.z * a[2]; x.w += gt.w * a[3];
    if (!g.dry) *xp = x;
  } else {
    uint2 o; o.x = pack2(a[0], a[1]); o.y = pack2(a[2], a[3]);
    *(uint2*)(g.o16 + (size_t)m * DFF2 + n) = o;
  }
}


__device__ __forceinline__ void ffn_conv8(const float (&g0)[8], const float (&g1)[8], const float (&g2)[8], const float (&v0)[8], const float (&v1)[8], const float (&v2)[8],
                                          const float (&wg)[3][8], const float (&wv)[3][8], const float (&bg)[8], const float (&bv)[8], float (&o)[8]) {
#pragma unroll
  for (int e = 0; e < 8; ++e) {
    const float gc = bg[e] + g0[e] * wg[0][e] + g1[e] * wg[1][e] + g2[e] * wg[2][e];
    const float vc = bv[e] + v0[e] * wv[0][e] + v1[e] * wv[1][e] + v2[e] * wv[2][e];
    o[e] = fsilu(gc) * vc;
  }
}
__device__ __forceinline__ void ld8(const float* p, float (&x)[8]) {
  const float4 a = *(const float4*)p, b = *(const float4*)(p + 4);
  x[0] = a.x; x[1] = a.y; x[2] = a.z; x[3] = a.w; x[4] = b.x; x[5] = b.y; x[6] = b.z; x[7] = b.w;
}
__device__ __forceinline__ void ffn_load_w(const float* cw, const float* cb, int ch, float (&wg)[3][8], float (&wv)[3][8], float (&bg)[8], float (&bv)[8]) {
#pragma unroll
  for (int j = 0; j < 3; ++j) { ld8(cw + j * DFF2 + ch, wg[j]); ld8(cw + j * DFF2 + DFF + ch, wv[j]); }
  ld8(cb + ch, bg); ld8(cb + DFF + ch, bv);
}
__device__ __forceinline__ void ffn_tile_epilogue(const GemmArgs& g, const float* Ut, int m0, int nt, int tid) {
  const int c8 = (tid & 7) * 8, ts = (tid >> 3) * 4;
  const int ch = nt * 64 + c8;
  float wg[3][8], wv[3][8], bg[8], bv[8];
  ffn_load_w(g.cw, g.cb, ch, wg, wv, bg, bv);
  int s0, len; tok_seq(m0, s0, len);
  const bool seq_start = (m0 == s0), seq_end = (m0 + 128 == s0 + len);
  float g0[8], g1[8], g2[8], v0[8], v1[8], v2[8];
  if (ts > 0) { ld8(Ut + (ts - 1) * 132 + c8, g0); ld8(Ut + (ts - 1) * 132 + 64 + c8, v0); }
  else {
#pragma unroll
    for (int e = 0; e < 8; ++e) { g0[e] = 0.f; v0[e] = 0.f; }
  }
  ld8(Ut + ts * 132 + c8, g1); ld8(Ut + ts * 132 + 64 + c8, v1);
#pragma unroll
  for (int ii = 0; ii < 4; ++ii) {
    const int t = ts + ii;
    if (t + 1 < 128) { ld8(Ut + (t + 1) * 132 + c8, g2); ld8(Ut + (t + 1) * 132 + 64 + c8, v2); }
    else {
#pragma unroll
      for (int e = 0; e < 8; ++e) { g2[e] = 0.f; v2[e] = 0.f; }
    }
    float o[8];
    ffn_conv8(g0, g1, g2, v0, v1, v2, wg, wv, bg, bv, o);
    const bool skip = (t == 0 && !seq_start) || (t == 127 && !seq_end);
    if (!skip) *(uint4*)(g.o16 + (size_t)(m0 + t) * DFF + ch) = pack8(o);
#pragma unroll
    for (int e = 0; e < 8; ++e) { g0[e] = g1[e]; g1[e] = g2[e]; v0[e] = v1[e]; v1[e] = v2[e]; }
  }
  if (tid < 128) {
    const int rs = tid >> 5, c4 = (tid & 31) * 4;
    const int row = rs < 2 ? rs : 124 + rs;
    *(float4*)(g.halo + ((size_t)((m0 >> 7) * 4 + rs)) * DFF2 + nt * 128 + c4) = *(const float4*)(Ut + row * 132 + c4);
  }
}
__device__ __forceinline__ void ffn_fixup(const P& p, int layer) {
  const float* HALO = (const float*)(p.ws + WS_STATES);
  bf16_t* ACT = (bf16_t*)(p.ws + WS_REGION);
  const float* cw = p.in[30] + (size_t)layer * 3 * DFF2;
  const float* cb = p.in[31] + (size_t)layer * DFF2;
  const int total = 191 * 2 * 352;
  for (int idx = BID() * 256 + TID(); idx < total; idx += gridDim.x * 256) {
    const int kg = idx % 352, r = idx / 352;
    const int side = r & 1, mt = r >> 1;
    const int tb = (mt + 1) * 128;
    const bool is_start = tb < T_PROMPT ? ((tb & 255) == 0) : (((tb - T_PROMPT) & 4095) == 0);
    if (is_start) continue;
    const int ch = kg * 8;
    const int hc = (ch >> 6) * 128 + (ch & 63);
    float wg[3][8], wv[3][8], bg[8], bv[8];
    ffn_load_w(cw, cb, ch, wg, wv, bg, bv);
    const float* r0 = HALO + ((size_t)(mt * 4 + (side == 0 ? 2 : 3))) * DFF2 + hc;
    const float* r1 = side == 0 ? HALO + ((size_t)(mt * 4 + 3)) * DFF2 + hc : HALO + ((size_t)((mt + 1) * 4 + 0)) * DFF2 + hc;
    const float* r2 = HALO + ((size_t)((mt + 1) * 4 + (side == 0 ? 0 : 1))) * DFF2 + hc;
    float g0[8], g1[8], g2[8], v0[8], v1[8], v2[8], o[8];
    ld8(r0, g0); ld8(r0 + 64, v0); ld8(r1, g1); ld8(r1 + 64, v1); ld8(r2, g2); ld8(r2 + 64, v2);
    ffn_conv8(g0, g1, g2, v0, v1, v2, wg, wv, bg, bv, o);
    const int t = side == 0 ? tb - 1 : tb;
    *(uint4*)(ACT + (size_t)t * DFF + ch) = pack8(o);
  }
}

__device__ __forceinline__ int gemm_fetch_tile(unsigned* qc, int q0, int nq) {
  for (int k = 0; k < 8; ++k) {
    const int qq = (q0 + k) & 7;
    const unsigned idx = __hip_atomic_fetch_add(qc + qq * 16, 1u, __ATOMIC_RELAXED, __HIP_MEMORY_SCOPE_AGENT);
    if (idx < (unsigned)nq) return qq * nq + (int)idx;
  }
  return -1;
}

template <int EPI>
__device__ __forceinline__ void gemm_phase(const GemmArgs& g, char* lds) {
  bf16_t* sAb = (bf16_t*)lds;
  LAS char* ldsl = (LAS char*)lds;
  bf16_t* sBb = sAb + 2 * 128 * 64;
  const int tid = TID(), lane = tid & 63, w = __builtin_amdgcn_readfirstlane(tid >> 6);
  const int wm = (w & 1) * 64, wn = (w >> 1) * 64;
  const int ntn = g.NP >> 7, ntm = g.M >> 7;
  const int KT = g.K >> 6;
  const int lrow = tid >> 3, lkc = (tid & 7) * 8;
  const int skc = ((tid & 7) ^ ((lrow >> 1) & 7)) * 8;
  const int band = 8 * ntn;
  const int nq = (ntm * ntn) >> 3;
  const int q0 = (int)((unsigned)__builtin_amdgcn_s_getreg((3 << 11) | 20) & 7u);
  volatile int* slot = (volatile int*)(lds - 16) + 2;
  if (tid == 0) *slot = gemm_fetch_tile(g.qctr, q0, nq);
  __syncthreads();
  int tile = __builtin_amdgcn_readfirstlane(*slot);
  while (tile >= 0) {
    const int bd = tile / band, within = tile - bd * band;
    const int nt = within >> 3, mt = bd * 8 + (within & 7);
    const int m0 = mt << 7, n0 = nt << 7;
    const bf16_t* gA = g.A + (size_t)(m0 + lrow) * g.lda + skc;
    const bf16_t* gB = g.Bt + (size_t)(n0 + lrow) * g.K + skc;
    const size_t sa32 = (size_t)32 * g.lda, sb32 = (size_t)32 * g.K;
    f32x4 acc[4][4];
#pragma unroll
    for (int a = 0; a < 4; ++a)
#pragma unroll
      for (int c = 0; c < 4; ++c) acc[a][c] = (f32x4){0.f, 0.f, 0.f, 0.f};
#define GLDS_TILE(kt_, buf_) do { \
      const bf16_t* a2_ = gA + (size_t)(kt_) * 64; const bf16_t* b2_ = gB + (size_t)(kt_) * 64; \
      LAS char* dA_ = ldsl + (buf_) * 16384 + w * 1024; LAS char* dB_ = ldsl + 32768 + (buf_) * 16384 + w * 1024; \
      _Pragma("unroll") for (int i_ = 0; i_ < 4; ++i_) { \
        __builtin_amdgcn_global_load_lds((const unsigned*)(a2_ + i_ * sa32), (LAS unsigned*)(dA_ + i_ * 4096), 16, 0, 0); \
        __builtin_amdgcn_global_load_lds((const unsigned*)(b2_ + i_ * sb32), (LAS unsigned*)(dB_ + i_ * 4096), 16, 0, 0); } } while (0)
    GLDS_TILE(0, 0);
    asm volatile("s_waitcnt vmcnt(0)" ::: "memory");
    __syncthreads();
    int nxt = -1;
    if (tid == 0) nxt = gemm_fetch_tile(g.qctr, q0, nq);
    for (int kt = 0; kt < KT; ++kt) {
      if (kt == 1 && tid == 0) *slot = nxt;
      const bf16_t* sA = sAb + (kt & 1) * (128 * 64);
      const bf16_t* sB = sBb + (kt & 1) * (128 * 64);
#pragma unroll
      for (int ks = 0; ks < 2; ++ks) {
        bf16x8 bfr[4], afr[4];
#pragma unroll
        for (int im = 0; im < 4; ++im) bfr[im] = frag_sw(sA, wm + im * 16, ks, lane);
#pragma unroll
        for (int jn = 0; jn < 4; ++jn) afr[jn] = frag_sw(sB, wn + jn * 16, ks, lane);
        if (ks == 0 && kt + 1 < KT) GLDS_TILE(kt + 1, (kt + 1) & 1);
        __builtin_amdgcn_s_setprio(1);
#pragma unroll
        for (int jn = 0; jn < 4; ++jn)
#pragma unroll
          for (int im = 0; im < 4; ++im) acc[jn][im] = mfma16(afr[jn], bfr[im], acc[jn][im]);
        __builtin_amdgcn_s_setprio(0);
      }
      asm volatile("s_waitcnt vmcnt(0)" ::: "memory");
      __syncthreads();
    }
#undef GLDS_TILE
    const int tile_next = __builtin_amdgcn_readfirstlane(*slot);
    if (EPI == 3) {
      float* Ut = (float*)lds;
#pragma unroll
      for (int jn = 0; jn < 4; ++jn)
#pragma unroll
        for (int im = 0; im < 4; ++im) {
          float4 f; f.x = acc[jn][im][0]; f.y = acc[jn][im][1]; f.z = acc[jn][im][2]; f.w = acc[jn][im][3];
          *(float4*)(Ut + (wm + im * 16 + (lane & 15)) * 132 + wn + jn * 16 + (lane >> 4) * 4) = f;
        }
      __syncthreads();
      ffn_tile_epilogue(g, Ut, m0, nt, tid);
      __syncthreads();
    } else {
#pragma unroll
      for (int jn = 0; jn < 4; ++jn)
#pragma unroll
        for (int im = 0; im < 4; ++im)
          gemm_epi<EPI>(g, m0 + wm + im * 16 + (lane & 15), n0 + wn + jn * 16 + (lane >> 4) * 4, acc[jn][im]);
    }
    tile = tile_next;
  }
}

#define ATT_ROPE_OFF ((128 + 64 + 64 + 128) * 72 * 2)
__device__ __forceinline__ void attn_stage_rope(const P& p, char* lds) {
  const float* rope = (const float*)(p.ws + WS_ROPE);
  float* rl = (float*)(lds + ATT_ROPE_OFF);
  const int tid = TID();
  __syncthreads();
#pragma unroll
  for (int e = 0; e < 8; ++e) rl[tid + 256 * e] = rope[tid + 256 * e];
  __syncthreads();
}
__device__ __forceinline__ void rope16(float* x, const float* y, const float* rl, int idx, int sg) {
#pragma unroll
  for (int e = 0; e < 16; ++e) {
    const float2 cs = *(const float2*)(rl + (idx * 16 + e) * 2);
    x[e] = (sg & 1) ? (y[e] * cs.y + x[e] * cs.x) : (x[e] * cs.x - y[e] * cs.y);
  }
}
__device__ __forceinline__ void unpackf4(uint4 r, float* x) {
  x[0] = __uint_as_float(r.x); x[1] = __uint_as_float(r.y); x[2] = __uint_as_float(r.z); x[3] = __uint_as_float(r.w);
}
__device__ __forceinline__ void attn_item(const P& p, int item, int jl, char* lds) {
  bf16_t* Qs = (bf16_t*)lds; bf16_t* Ks = Qs + 128 * 72; bf16_t* VT = Ks + 64 * 72; bf16_t* Ps = VT + 64 * 72;
  const float* rl = (const float*)(lds + ATT_ROPE_OFF);
  const bf16_t* PJ = (const bf16_t*)(p.ws + WS_REGION);
  bf16_t* MIX = (bf16_t*)(p.ws + WS_H);
  const int tid = TID(), lane = tid & 63, w = tid >> 6;
  bool latent; int seq, q0, hq;
  if (item < 1024) { latent = true; hq = item & 7; int r = item >> 3; q0 = (r & 31) * 128; seq = r >> 5; }
  else { latent = false; int r = item - 1024; hq = r & 7; r >>= 3; q0 = (r & 1) * 128; seq = r >> 1; }
  const int tbase = latent ? T_PROMPT + seq * 4096 : seq * 256;
  const int kvh = hq >> 2;
  const int u_lo = latent ? (q0 >= 128 ? 0 : (128 - q0) >> 6) : 0;
  const int u_hi = latent ? ((4160 - q0) >> 6 < 5 ? (4160 - q0) >> 6 : 5) : 3;
  const int nw = u_hi - u_lo + 1;
  const int ntiles = latent ? nw + 4 : 4;
  const int krow = tid >> 2, ksg = tid & 3, vkey = tid & 63, vsg = tid >> 6;
  uint4 k0, k1, k2, k3, v0, v1, v2, v3;
  k0 = k1 = k2 = k3 = v0 = v1 = v2 = v3 = make_uint4(0u, 0u, 0u, 0u);
#define ATT_TILE(j_, mode_, kp0_) do { if (latent) { if ((j_) < nw) { mode_ = 0; kp0_ = q0 - 128 + 64 * (u_lo + (j_)); } else { mode_ = 2; kp0_ = ((j_) - nw) * 64; } } else { mode_ = 1; kp0_ = (j_) * 64; } } while (0)
#define ATT_LOAD(j_) do { int mode_, kp0_; ATT_TILE(j_, mode_, kp0_); \
    if (mode_ == 2) { \
      const float* ks_ = p.in[2] + ((size_t)(((seq * 2 + jl) * 256 + kp0_ + krow) * 2 + kvh)) * 64 + ksg * 16; \
      const float* vs_ = p.in[3] + ((size_t)(((seq * 2 + jl) * 256 + kp0_ + vkey) * 2 + kvh)) * 64 + vsg * 16; \
      k0 = *(const uint4*)(ks_); k1 = *(const uint4*)(ks_ + 4); k2 = *(const uint4*)(ks_ + 8); k3 = *(const uint4*)(ks_ + 12); \
      v0 = *(const uint4*)(vs_); v1 = *(const uint4*)(vs_ + 4); v2 = *(const uint4*)(vs_ + 8); v3 = *(const uint4*)(vs_ + 12); \
    } else { \
      const bf16_t* ks_ = PJ + (size_t)(tbase + kp0_ + krow) * EV_IN + 512 + kvh * 64; \
      const bf16_t* vs_ = PJ + (size_t)(tbase + kp0_ + vkey) * EV_IN + 640 + kvh * 64 + vsg * 16; \
      k0 = *(const uint4*)(ks_ + ksg * 16); k1 = *(const uint4*)(ks_ + ksg * 16 + 8); \
      if (mode_ == 0) { k2 = *(const uint4*)(ks_ + (ksg ^ 1) * 16); k3 = *(const uint4*)(ks_ + (ksg ^ 1) * 16 + 8); } \
      v0 = *(const uint4*)(vs_); v1 = *(const uint4*)(vs_ + 8); \
    } } while (0)
  ATT_LOAD(0);
  __syncthreads();
#pragma unroll
  for (int hh = 0; hh < 2; ++hh) {
    const int qr = krow + 64 * hh;
    const bf16_t* src = PJ + (size_t)(tbase + q0 + qr) * EV_IN + hq * 64;
    if (latent) {
      float x[16], y[16];
      unpack8(*(const uint4*)(src + ksg * 16), x); unpack8(*(const uint4*)(src + ksg * 16 + 8), x + 8);
      unpack8(*(const uint4*)(src + (ksg ^ 1) * 16), y); unpack8(*(const uint4*)(src + (ksg ^ 1) * 16 + 8), y + 8);
      const int pos = q0 + qr;
      rope16(x, y, rl, (ksg < 2) ? (pos >> 6) : (pos & 63), ksg);
      *(uint4*)(Qs + qr * 72 + ksg * 16) = pack8(x);
      *(uint4*)(Qs + qr * 72 + ksg * 16 + 8) = pack8(x + 8);
    } else {
      *(uint4*)(Qs + qr * 72 + ksg * 16) = *(const uint4*)(src + ksg * 16);
      *(uint4*)(Qs + qr * 72 + ksg * 16 + 8) = *(const uint4*)(src + ksg * 16 + 8);
    }
  }
  const float SC = 0.125f * LOG2E;
  const float sinkl = p.in[13][jl * 8 + hq] * LOG2E;
  float m_run[2] = {sinkl, sinkl}, l_run[2] = {1.f, 1.f};
  f32x4 oacc[2][4];
#pragma unroll
  for (int g = 0; g < 2; ++g)
#pragma unroll
    for (int i = 0; i < 4; ++i) oacc[g][i] = (f32x4){0.f, 0.f, 0.f, 0.f};
  for (int j = 0; j < ntiles; ++j) {
    int mode, kp0; ATT_TILE(j, mode, kp0);
    if (j > 0) __syncthreads();
    {
      float x[16];
      if (mode == 1) {
        *(uint4*)(Ks + krow * 72 + ksg * 16) = k0;
        *(uint4*)(Ks + krow * 72 + ksg * 16 + 8) = k1;
      } else {
        if (mode == 2) { unpackf4(k0, x); unpackf4(k1, x + 4); unpackf4(k2, x + 8); unpackf4(k3, x + 12); }
        else {
          unpack8(k0, x); unpack8(k1, x + 8);
          float y[16]; unpack8(k2, y); unpack8(k3, y + 8);
          const int pos = kp0 + krow;
          rope16(x, y, rl, (ksg < 2) ? (pos >> 6) : (pos & 63), ksg);
        }
        *(uint4*)(Ks + krow * 72 + ksg * 16) = pack8(x);
        *(uint4*)(Ks + krow * 72 + ksg * 16 + 8) = pack8(x + 8);
      }
      if (mode == 2) {
        unpackf4(v0, x); unpackf4(v1, x + 4); unpackf4(v2, x + 8); unpackf4(v3, x + 12);
#pragma unroll
        for (int e = 0; e < 8; ++e) {
          const unsigned int pk = pack2(x[2 * e], x[2 * e + 1]);
          VT[(vsg * 16 + 2 * e) * 72 + vkey] = (bf16_t)(pk & 0xffffu);
          VT[(vsg * 16 + 2 * e + 1) * 72 + vkey] = (bf16_t)(pk >> 16);
        }
      } else {
        const unsigned int u[8] = {v0.x, v0.y, v0.z, v0.w, v1.x, v1.y, v1.z, v1.w};
#pragma unroll
        for (int e = 0; e < 8; ++e) {
          VT[(vsg * 16 + 2 * e) * 72 + vkey] = (bf16_t)(u[e] & 0xffffu);
          VT[(vsg * 16 + 2 * e + 1) * 72 + vkey] = (bf16_t)(u[e] >> 16);
        }
      }
    }
    if (j + 1 < ntiles) ATT_LOAD(j + 1);
    __syncthreads();
    const bool need_mask = (mode == 0) && (kp0 != q0) && (kp0 != q0 + 64);
#pragma unroll
    for (int g = 0; g < 2; ++g) {
      const int qi = 32 * w + 16 * g + (lane & 15);
      f32x4 s[4];
#pragma unroll
      for (int i = 0; i < 4; ++i) s[i] = (f32x4){0.f, 0.f, 0.f, 0.f};
      __builtin_amdgcn_s_setprio(1);
#pragma unroll
      for (int ks = 0; ks < 2; ++ks) {
        const bf16x8 bq = frag(Qs, 32 * w + 16 * g, ks, lane);
#pragma unroll
        for (int kt = 0; kt < 4; ++kt) s[kt] = mfma16(frag(Ks, kt * 16, ks, lane), bq, s[kt]);
      }
      __builtin_amdgcn_s_setprio(0);
      float mx = -3.0e38f;
#pragma unroll
      for (int kt = 0; kt < 4; ++kt)
#pragma unroll
        for (int r = 0; r < 4; ++r) {
          float v = s[kt][r] * SC;
          if (need_mask) {
            const int kp = kp0 + kt * 16 + (lane >> 4) * 4 + r;
            const int dlt = kp - (q0 + qi);
            if (dlt > 128 || dlt < -128) v = -1.0e30f;
          }
          s[kt][r] = v; mx = fmaxf(mx, v);
        }
      mx = fmaxf(mx, __shfl_xor(mx, 16)); mx = fmaxf(mx, __shfl_xor(mx, 32));
      const float m_new = fmaxf(m_run[g], mx);
      const float alpha = __builtin_amdgcn_exp2f(m_run[g] - m_new);
      float rs = 0.f;
#pragma unroll
      for (int kt = 0; kt < 4; ++kt) {
        float p0 = __builtin_amdgcn_exp2f(s[kt][0] - m_new), p1 = __builtin_amdgcn_exp2f(s[kt][1] - m_new), p2 = __builtin_amdgcn_exp2f(s[kt][2] - m_new), p3 = __builtin_amdgcn_exp2f(s[kt][3] - m_new);
        rs += (p0 + p1) + (p2 + p3);
        uint2 o; o.x = pack2(p0, p1); o.y = pack2(p2, p3);
        *(uint2*)(Ps + qi * 72 + kt * 16 + (lane >> 4) * 4) = o;
      }
      rs += __shfl_xor(rs, 16); rs += __shfl_xor(rs, 32);
      l_run[g] = l_run[g] * alpha + rs; m_run[g] = m_new;
#pragma unroll
      for (int i = 0; i < 4; ++i) { oacc[g][i][0] *= alpha; oacc[g][i][1] *= alpha; oacc[g][i][2] *= alpha; oacc[g][i][3] *= alpha; }
    }
    __syncthreads();
    __builtin_amdgcn_s_setprio(1);
#pragma unroll
    for (int g = 0; g < 2; ++g)
#pragma unroll
      for (int ks = 0; ks < 2; ++ks) {
        const bf16x8 bp = frag(Ps, 32 * w + 16 * g, ks, lane);
#pragma unroll
        for (int dt = 0; dt < 4; ++dt) oacc[g][dt] = mfma16(frag(VT, dt * 16, ks, lane), bp, oacc[g][dt]);
      }
    __builtin_amdgcn_s_setprio(0);
  }
#undef ATT_LOAD
#undef ATT_TILE
#pragma unroll
  for (int g = 0; g < 2; ++g) {
    const int qi = 32 * w + 16 * g + (lane & 15);
    const float inv = __builtin_amdgcn_rcpf(l_run[g]);
#pragma unroll
    for (int dt = 0; dt < 4; ++dt) {
      uint2 o; o.x = pack2(oacc[g][dt][0] * inv, oacc[g][dt][1] * inv); o.y = pack2(oacc[g][dt][2] * inv, oacc[g][dt][3] * inv);
      *(uint2*)(MIX + (size_t)(tbase + q0 + qi) * 1024 + hq * 64 + dt * 16 + (lane >> 4) * 4) = o;
    }
  }
}

__device__ __forceinline__ uint2 gla_r_load(const bf16_t* PJ, int t0, int dir, int tid) {
  const int i = tid >> 2, r4 = (tid & 3) * 4;
  return *(const uint2*)(PJ + (size_t)(t0 + i) * EV_IN + 2304 + dir * 16 + r4);
}
__device__ __forceinline__ void gla_r_store(uint2 raw, float* rt, int tid) {
  const int i = tid >> 2, r4 = (tid & 3) * 4;
  rt[i * 16 + r4] = bflo(raw.x); rt[i * 16 + r4 + 1] = bfhi(raw.x); rt[i * 16 + r4 + 2] = bflo(raw.y); rt[i * 16 + r4 + 3] = bfhi(raw.y);
}
__device__ __forceinline__ void gla_gates(const P& p, int h, int dir, int jl, const float* rt, float* seg, float* b, float& tot) {
  const int tid = TID();
  const int d = tid & 63, q = tid >> 6;
  const float* wg = (dir == 0 ? p.in[14] : p.in[16]) + jl * 16 * 256 + h * 64 + d;
  const float bias = (dir == 0 ? p.in[15] : p.in[17])[jl * 256 + h * 64 + d];
  float wv[16];
#pragma unroll
  for (int r = 0; r < 16; ++r) wv[r] = wg[r * 256];
#pragma unroll
  for (int ii = 0; ii < 16; ++ii) {
    const float* rr = rt + (16 * q + ii) * 16;
    float z = bias;
#pragma unroll
    for (int r = 0; r < 16; ++r) z += rr[r] * wv[r];
    b[ii] = flogsig(z) * (1.f / 16.f);
  }
  float run = 0.f;
  if (dir == 0) {
#pragma unroll
    for (int ii = 0; ii < 16; ++ii) { run += b[ii]; b[ii] = run; }
  } else {
#pragma unroll
    for (int ii = 15; ii >= 0; --ii) { run += b[ii]; b[ii] = run; }
  }
  seg[q * 64 + d] = run;
  __syncthreads();
  const float s0 = seg[d], s1 = seg[64 + d], s2 = seg[128 + d], s3 = seg[192 + d];
  tot = (s0 + s1) + (s2 + s3);
  float off;
  if (dir == 0) off = (q > 0 ? s0 : 0.f) + (q > 1 ? s1 : 0.f) + (q > 2 ? s2 : 0.f);
  else off = (q < 3 ? s3 : 0.f) + (q < 2 ? s2 : 0.f) + (q < 1 ? s1 : 0.f);
#pragma unroll
  for (int ii = 0; ii < 16; ++ii) b[ii] += off;
}

__device__ __forceinline__ void gla_pass1_item(const P& p, int item, int jl, char* lds) {
  float* rt = (float*)lds; float* rt2 = rt + 1024; float* seg = rt2 + 1024;
  bf16_t* KtT = (bf16_t*)(seg + 256);
  bf16_t* VT = KtT + 64 * 72;
  const bf16_t* PJ = (const bf16_t*)(p.ws + WS_REGION);
  bf16_t* STATES = (bf16_t*)(p.ws + WS_STATES);
  float* GA = (float*)(p.ws + WS_GLA_A);
  const int tid = TID(), lane = tid & 63, w = tid >> 6;
  const int h = item & 3, cgk = item >> 2;
  const int t0 = cgk * 64;
  const int d = tid & 63, q = tid >> 6;
  const uint2 r0 = gla_r_load(PJ, t0, 0, tid), r1 = gla_r_load(PJ, t0, 1, tid);
  float kraw[16];
#pragma unroll
  for (int ii = 0; ii < 16; ++ii) kraw[ii] = bf2f(PJ[(size_t)(t0 + 16 * q + ii) * EV_IN + 1024 + h * 64 + d]);
  uint4 vraw[4];
  {
    const bf16_t* src = PJ + (size_t)(t0 + (tid & 63)) * EV_IN + 1280 + h * 128 + (tid >> 6) * 32;
#pragma unroll
    for (int c = 0; c < 4; ++c) vraw[c] = *(const uint4*)(src + c * 8);
  }
  __syncthreads();
  gla_r_store(r0, rt, tid); gla_r_store(r1, rt2, tid);
  {
    const int i = tid & 63, sg = tid >> 6;
#pragma unroll
    for (int c = 0; c < 4; ++c) {
      const unsigned int u[4] = {vraw[c].x, vraw[c].y, vraw[c].z, vraw[c].w};
#pragma unroll
      for (int e = 0; e < 4; ++e) {
        VT[(sg * 32 + c * 8 + 2 * e) * 72 + i] = (bf16_t)(u[e] & 0xffffu);
        VT[(sg * 32 + c * 8 + 2 * e + 1) * 72 + i] = (bf16_t)(u[e] >> 16);
      }
    }
  }
  __syncthreads();
#pragma unroll
  for (int dir = 0; dir < 2; ++dir) {
    float b[16], tot;
    gla_gates(p, h, dir, jl, dir == 0 ? rt : rt2, seg, b, tot);
    {
      float kt[16];
#pragma unroll
      for (int ii = 0; ii < 16; ++ii) kt[ii] = kraw[ii] * __expf(tot - b[ii]);
      *(uint4*)(KtT + d * 72 + 16 * q) = pack8(kt);
      *(uint4*)(KtT + d * 72 + 16 * q + 8) = pack8(kt + 8);
    }
    __syncthreads();
    f32x4 acc[8];
#pragma unroll
    for (int i = 0; i < 8; ++i) acc[i] = (f32x4){0.f, 0.f, 0.f, 0.f};
#pragma unroll
    for (int ks = 0; ks < 2; ++ks) {
      const bf16x8 ak = frag(KtT, 16 * w, ks, lane);
#pragma unroll
      for (int vt = 0; vt < 8; ++vt) acc[vt] = mfma16(ak, frag(VT, vt * 16, ks, lane), acc[vt]);
    }
    const size_t sidx = (size_t)((cgk * 4 + h) * 2 + dir);
#pragma unroll
    for (int vt = 0; vt < 8; ++vt) {
      uint2 o; o.x = pack2(acc[vt][0], acc[vt][1]); o.y = pack2(acc[vt][2], acc[vt][3]);
      *(uint2*)(STATES + sidx * 8192 + (vt * 16 + (lane & 15)) * 64 + 16 * w + (lane >> 4) * 4) = o;
    }
    if (tid < 64) GA[sidx * 64 + tid] = __expf(tot);
    __syncthreads();
  }
}

__device__ __forceinline__ void gla_pass2_item(const P& p, int item, int jl, int dry = 0) {
  bf16_t* STATES = (bf16_t*)(p.ws + WS_STATES);
  const float* GA = (const float*)(p.ws + WS_GLA_A);
  const int tid = TID();
  bool sample; int stream, slab;
  if (item < 256) { sample = true; stream = item >> 3; slab = item & 7; }
  else { sample = false; stream = (item - 256) >> 3; slab = item & 7; }
  const int dir = stream & 1, h = (stream >> 1) & 3, sq = stream >> 3;
  const int chunk0 = sample ? 128 + sq * 64 : sq * 4;
  const int nch = sample ? 64 : 4;
  const int e = slab * 1024 + tid * 4;
  const int v = e >> 6, d = e & 63;
  float4 s = make_float4(0.f, 0.f, 0.f, 0.f);
  if (sample) {
    const float* S0 = p.in[4] + ((size_t)(((sq * 2 + jl) * 2 + dir) * 4 + h)) * 8192;
    s.x = S0[(d + 0) * 128 + v]; s.y = S0[(d + 1) * 128 + v]; s.z = S0[(d + 2) * 128 + v]; s.w = S0[(d + 3) * 128 + v];
  }
  for (int base = 0; base < nch; base += 4) {
    float4 dS[4], a[4]; size_t sx[4];
#pragma unroll
    for (int k = 0; k < 4; ++k) {
      const int c = dir == 0 ? chunk0 + base + k : chunk0 + nch - 1 - (base + k);
      sx[k] = (size_t)((c * 4 + h) * 2 + dir);
      { const uint2 raw = *(const uint2*)(STATES + sx[k] * 8192 + e); dS[k] = make_float4(bflo(raw.x), bfhi(raw.x), bflo(raw.y), bfhi(raw.y)); }
      a[k] = *(const float4*)(GA + sx[k] * 64 + d);
    }
#pragma unroll
    for (int k = 0; k < 4; ++k) {
      if (!dry) { uint2 o; o.x = pack2(s.x, s.y); o.y = pack2(s.z, s.w); *(uint2*)(STATES + sx[k] * 8192 + e) = o; }
      s.x = a[k].x * s.x + dS[k].x; s.y = a[k].y * s.y + dS[k].y; s.z = a[k].z * s.z + dS[k].z; s.w = a[k].w * s.w + dS[k].w;
    }
  }
  if (!sample && !dry) {
    float* o = p.out + OUT_GLA + ((size_t)(((sq * 2 + jl) * 2 + dir) * 4 + h)) * 8192;
    o[(d + 0) * 128 + v] = s.x; o[(d + 1) * 128 + v] = s.y; o[(d + 2) * 128 + v] = s.z; o[(d + 3) * 128 + v] = s.w;
  }
}

__device__ __forceinline__ void gla_pass3_item(const P& p, int item, int jl, char* lds) {
  float* rt = (float*)lds; float* seg = rt + 1024;
  bf16_t* Qs = (bf16_t*)(seg + 256); bf16_t* Ks = Qs + 64 * 72; bf16_t* VT = Ks + 64 * 72; bf16_t* ST = VT + 128 * 72; bf16_t* Ps = ST + 128 * 72;
  const bf16_t* PJ = (const bf16_t*)(p.ws + WS_REGION);
  const bf16_t* STATES = (const bf16_t*)(p.ws + WS_STATES);
  bf16_t* MIX = (bf16_t*)(p.ws + WS_H);
  const int tid = TID(), lane = tid & 63, w = tid >> 6;
  const int h = item & 3, cgk = item >> 2;
  const int t0 = cgk * 64;
  uint4 vraw[4];
  {
    const int i = tid & 63, sg = tid >> 6;
    const bf16_t* src = PJ + (size_t)(t0 + i) * EV_IN + 1280 + h * 128 + sg * 32;
#pragma unroll
    for (int c = 0; c < 4; ++c) vraw[c] = *(const uint4*)(src + c * 8);
  }
  f32x4 acc[8];
#pragma unroll
  for (int i = 0; i < 8; ++i) acc[i] = (f32x4){0.f, 0.f, 0.f, 0.f};
  const int iq = 16 * w + (lane & 15);
#pragma unroll
  for (int dir = 0; dir < 2; ++dir) {
    const uint2 rr = gla_r_load(PJ, t0, dir, tid);
    const int lrow = tid >> 2, lsg = (tid & 3) * 16;
    const bf16_t* qsrc = PJ + (size_t)(t0 + lrow) * EV_IN + 768 + h * 64 + lsg;
    const uint4 q0 = *(const uint4*)qsrc, q1 = *(const uint4*)(qsrc + 8), k0 = *(const uint4*)(qsrc + 256), k1 = *(const uint4*)(qsrc + 264);
    const size_t sidx = (size_t)((cgk * 4 + h) * 2 + dir);
    const bf16_t* stp = STATES + sidx * 8192 + tid * 8;
    const uint4 st0 = *(const uint4*)(stp), st1 = *(const uint4*)(stp + 2048), st2 = *(const uint4*)(stp + 4096), st3 = *(const uint4*)(stp + 6144);
    __syncthreads();
    gla_r_store(rr, rt, tid);
    *(uint4*)(Qs + lrow * 72 + lsg) = q0; *(uint4*)(Qs + lrow * 72 + lsg + 8) = q1;
    *(uint4*)(Ks + lrow * 72 + lsg) = k0; *(uint4*)(Ks + lrow * 72 + lsg + 8) = k1;
    {
      const int e0 = tid * 8;
      bf16_t* dp = ST + (e0 >> 6) * 72 + (e0 & 63);
      *(uint4*)(dp) = st0; *(uint4*)(dp + 32 * 72) = st1; *(uint4*)(dp + 64 * 72) = st2; *(uint4*)(dp + 96 * 72) = st3;
    }
    if (dir == 0) {
      const int i = tid & 63, sg = tid >> 6;
#pragma unroll
      for (int c = 0; c < 4; ++c) {
        const unsigned int u[4] = {vraw[c].x, vraw[c].y, vraw[c].z, vraw[c].w};
#pragma unroll
        for (int e = 0; e < 4; ++e) {
          VT[(sg * 32 + c * 8 + 2 * e) * 72 + i] = (bf16_t)(u[e] & 0xffffu);
          VT[(sg * 32 + c * 8 + 2 * e + 1) * 72 + i] = (bf16_t)(u[e] >> 16);
        }
      }
    }
    __syncthreads();
    float b[16], tot;
    gla_gates(p, h, dir, jl, rt, seg, b, tot);
    {
      const int d = tid & 63, q = tid >> 6;
#pragma unroll
      for (int ii = 0; ii < 16; ++ii) {
        const int i = 16 * q + ii;
        const float qv = bf2f(Qs[i * 72 + d]), kv = bf2f(Ks[i * 72 + d]);
        Qs[i * 72 + d] = f2bf(qv * 0.125f * __expf(b[ii]));
        Ks[i * 72 + d] = f2bf(kv * __expf(-b[ii]));
      }
    }
    __syncthreads();
    f32x4 pa[4];
#pragma unroll
    for (int i = 0; i < 4; ++i) pa[i] = (f32x4){0.f, 0.f, 0.f, 0.f};
#pragma unroll
    for (int ks = 0; ks < 2; ++ks) {
      const bf16x8 bq = frag(Qs, 16 * w, ks, lane);
#pragma unroll
      for (int jt = 0; jt < 4; ++jt) pa[jt] = mfma16(frag(Ks, jt * 16, ks, lane), bq, pa[jt]);
    }
#pragma unroll
    for (int jt = 0; jt < 4; ++jt) {
      float pv[4];
#pragma unroll
      for (int r = 0; r < 4; ++r) {
        const int j = jt * 16 + (lane >> 4) * 4 + r;
        const bool keep = dir == 0 ? (j <= iq) : (j >= iq);
        pv[r] = keep ? pa[jt][r] : 0.f;
      }
      uint2 o; o.x = pack2(pv[0], pv[1]); o.y = pack2(pv[2], pv[3]);
      *(uint2*)(Ps + iq * 72 + jt * 16 + (lane >> 4) * 4) = o;
    }
    __syncthreads();
    __builtin_amdgcn_s_setprio(1);
#pragma unroll
    for (int ks = 0; ks < 2; ++ks) {
      const bf16x8 bq = frag(Qs, 16 * w, ks, lane);
      const bf16x8 bp = frag(Ps, 16 * w, ks, lane);
#pragma unroll
      for (int vt = 0; vt < 8; ++vt) {
        acc[vt] = mfma16(frag(ST, vt * 16, ks, lane), bq, acc[vt]);
        acc[vt] = mfma16(frag(VT, vt * 16, ks, lane), bp, acc[vt]);
      }
    }
    __builtin_amdgcn_s_setprio(0);
  }
  float ss = 0.f;
#pragma unroll
  for (int vt = 0; vt < 8; ++vt) ss += acc[vt][0] * acc[vt][0] + acc[vt][1] * acc[vt][1] + acc[vt][2] * acc[vt][2] + acc[vt][3] * acc[vt][3];
  ss += __shfl_xor(ss, 16); ss += __shfl_xor(ss, 32);
  const float rstd = __builtin_amdgcn_rsqf(ss * (1.f / 128.f) + 1e-6f);
  const int t = t0 + iq;
  const float* gn = p.in[18] + jl * 128;
#pragma unroll
  for (int vt = 0; vt < 8; ++vt) {
    const int v = vt * 16 + (lane >> 4) * 4;
    const uint2 graw = *(const uint2*)(PJ + (size_t)t * EV_IN + 1792 + h * 128 + v);
    const float4 g4 = *(const float4*)(gn + v);
    const float o0 = acc[vt][0] * rstd * g4.x * fsilu(bflo(graw.x));
    const float o1 = acc[vt][1] * rstd * g4.y * fsilu(bfhi(graw.x));
    const float o2 = acc[vt][2] * rstd * g4.z * fsilu(bflo(graw.y));
    const float o3 = acc[vt][3] * rstd * g4.w * fsilu(bfhi(graw.y));
    uint2 o; o.x = pack2(o0, o1); o.y = pack2(o2, o3);
    *(uint2*)(MIX + (size_t)t * 1024 + 512 + h * 128 + v) = o;
  }
}

__device__ __forceinline__ int sw_idx(int r, int c) { return r * 64 + ((((c >> 3) ^ (r >> 1)) & 7) << 3) + (c & 7); }
template <int PASS>
__device__ __forceinline__ void rg_item(const P& p, int item, int jl, char* lds) {
  bf16_t* XCb = (bf16_t*)lds;
  bf16_t* WT = XCb + 4096;
  float* As = (float*)(WT + 4 * 4096); float* Us = As + 64 * 65; float* segA = Us + 64 * 65; float* segU = segA + 256; float* bsm = segU + 256;
  const float* RGC = (const float*)(p.ws + WS_RGC);
  const float* CARRY = (const float*)(p.ws + WS_CARRY);
  const bf16_t* PJ2 = (const bf16_t*)(p.ws + WS_REGION);
  const bf16_t* WRG = (const bf16_t*)(p.ws + WS_WB) + WB_RG;
  float* AGG = (float*)(p.ws + WS_RGAGG);
  bf16_t* MIX = (bf16_t*)(p.ws + WS_H);
  const int tid = TID(), lane = tid & 63, w = tid >> 6;
  const int cgk = item >> 4, nb = item & 15;
  const int t0 = cgk * 64, ch0 = nb * 64;
  int s0, len; tok_seq(t0, s0, len);
  const int e_ = tid & 63, q = tid >> 6;
  const int ch = ch0 + e_;
  float xin[19];
  {
    const int tb = t0 + 16 * q - 2;
#pragma unroll
    for (int ii = 0; ii < 19; ++ii) { const int t = tb + ii; xin[ii] = (t >= s0 && t < s0 + len) ? bf2f(PJ2[(size_t)t * 2048 + 1024 + ch]) : 0.f; }
  }
  const float* cw = p.in[21] + jl * 4 * 1024 + ch;
  const float w0 = cw[0], w1 = cw[1024], w2 = cw[2048], w3 = cw[3072], cb = p.in[22][jl * 1024 + ch];
  const int wrow = tid >> 2, wsg = tid & 3;
  const bf16_t* wsrc = WRG + (size_t)nb * 4096 + wrow * 64 + wsg * 16;
  const uint4 wt00 = *(const uint4*)(wsrc), wt01 = *(const uint4*)(wsrc + 8);
  const uint4 wt10 = *(const uint4*)(wsrc + 16 * 4096), wt11 = *(const uint4*)(wsrc + 16 * 4096 + 8);
  const uint4 wt20 = *(const uint4*)(wsrc + 32 * 4096), wt21 = *(const uint4*)(wsrc + 32 * 4096 + 8);
  const uint4 wt30 = *(const uint4*)(wsrc + 48 * 4096), wt31 = *(const uint4*)(wsrc + 48 * 4096 + 8);
  float bs0 = 0.f, bs1 = 0.f;
  if (tid < 64) { bs0 = p.in[24][(jl * 2 + 0) * 1024 + ch0 + tid]; bs1 = p.in[24][(jl * 2 + 1) * 1024 + ch0 + tid]; }
  else if (tid < 128) { bs0 = p.in[26][(jl * 2 + 0) * 1024 + ch0 + tid - 64]; bs1 = p.in[26][(jl * 2 + 1) * 1024 + ch0 + tid - 64]; }
  else if (tid < 192) { bs0 = RGC[ch0 + tid - 128]; bs1 = RGC[1024 + ch0 + tid - 128]; }
  float cin0 = 0.f, cin1 = 0.f;
  if (PASS == 1) { cin0 = CARRY[(size_t)(cgk * 2 + 0) * 1024 + ch]; cin1 = CARRY[(size_t)(cgk * 2 + 1) * 1024 + ch]; }
  __syncthreads();
#pragma unroll
  for (int ii = 0; ii < 16; ++ii) {
    const float xc = cb + xin[ii] * w0 + xin[ii + 1] * w1 + xin[ii + 2] * w2 + xin[ii + 3] * w3;
    XCb[sw_idx(16 * q + ii, e_)] = f2bf(xc);
  }
  {
    const int s0_ = ((wsg * 2) ^ (wrow >> 1)) & 7, s1_ = ((wsg * 2 + 1) ^ (wrow >> 1)) & 7;
    bf16_t* d = WT + wrow * 64;
    *(uint4*)(d + s0_ * 8) = wt00; *(uint4*)(d + s1_ * 8) = wt01;
    *(uint4*)(d + 4096 + s0_ * 8) = wt10; *(uint4*)(d + 4096 + s1_ * 8) = wt11;
    *(uint4*)(d + 8192 + s0_ * 8) = wt20; *(uint4*)(d + 8192 + s1_ * 8) = wt21;
    *(uint4*)(d + 12288 + s0_ * 8) = wt30; *(uint4*)(d + 12288 + s1_ * 8) = wt31;
  }
  if (tid < 192) { bsm[tid] = bs0; bsm[192 + tid] = bs1; }
  float hsum[16];
#pragma unroll
  for (int ii = 0; ii < 16; ++ii) hsum[ii] = 0.f;
#pragma unroll
  for (int dir = 0; dir < 2; ++dir) {
    __syncthreads();
    const bf16_t* WTa = WT + (0 * 2 + dir) * 4096;
    const bf16_t* WTi = WT + (1 * 2 + dir) * 4096;
    const float* bs = bsm + dir * 192;
    f32x4 za[4], zi[4];
#pragma unroll
    for (int i = 0; i < 4; ++i) { za[i] = (f32x4){0.f, 0.f, 0.f, 0.f}; zi[i] = (f32x4){0.f, 0.f, 0.f, 0.f}; }
    __builtin_amdgcn_s_setprio(1);
#pragma unroll
    for (int ks = 0; ks < 2; ++ks) {
      const bf16x8 bx = frag_sw(XCb, 16 * w, ks, lane);
#pragma unroll
      for (int et = 0; et < 4; ++et) {
        za[et] = mfma16(frag_sw(WTa, et * 16, ks, lane), bx, za[et]);
        zi[et] = mfma16(frag_sw(WTi, et * 16, ks, lane), bx, zi[et]);
      }
    }
    __builtin_amdgcn_s_setprio(0);
    {
      const int i = 16 * w + (lane & 15);
#pragma unroll
      for (int et = 0; et < 4; ++et)
#pragma unroll
        for (int rp = 0; rp < 2; ++rp) {
          const int e = et * 16 + (lane >> 4) * 4 + 2 * rp;
          const f32x2_t zA = (f32x2_t){za[et][2 * rp], za[et][2 * rp + 1]} + (f32x2_t){bs[e], bs[e + 1]};
          const f32x2_t zI = (f32x2_t){zi[et][2 * rp], zi[et][2 * rp + 1]} + (f32x2_t){bs[64 + e], bs[64 + e + 1]};
          f32x2_t xa = zA * (-LOG2E), xi = zI * (-LOG2E);
          xa.x = fminf(xa.x, 60.f); xa.y = fminf(xa.y, 60.f); xi.x = fminf(xi.x, 60.f); xi.y = fminf(xi.y, 60.f);
          const f32x2_t ea = (f32x2_t){__builtin_amdgcn_exp2f(xa.x), __builtin_amdgcn_exp2f(xa.y)};
          const f32x2_t ei = (f32x2_t){__builtin_amdgcn_exp2f(xi.x), __builtin_amdgcn_exp2f(xi.y)};
          const f32x2_t pa = ea + 1.f, pi = ei + 1.f;
          const f32x2_t pp = pa * pi;
          const f32x2_t R = (f32x2_t){frcp(pp.x), frcp(pp.y)};
          const f32x2_t rr = pi * R, ig = pa * R;
          const f32x2_t la = rr * (f32x2_t){bs[128 + e], bs[128 + e + 1]};
          const f32x2_t t = la * (la * (la * (la * (la * 0.0083333338f + 0.041666668f) + 0.16666667f) + 0.5f) + 1.f);
          const f32x2_t em = -t * (t + 2.f);
          const unsigned int xraw = *(const unsigned int*)(XCb + sw_idx(i, e));
          const f32x2_t xc = (f32x2_t){bflo(xraw), bfhi(xraw)};
          const f32x2_t sq = (f32x2_t){__builtin_amdgcn_sqrtf(em.x), __builtin_amdgcn_sqrtf(em.y)};
          const f32x2_t av = t + 1.f, uv = sq * ig * xc;
          As[i * 65 + e] = av.x; As[i * 65 + e + 1] = av.y;
          Us[i * 65 + e] = uv.x; Us[i * 65 + e + 1] = uv.y;
        }
    }
    __syncthreads();
    float Ap = 1.f, Ua = 0.f;
    if (dir == 0) {
#pragma unroll
      for (int ii = 0; ii < 16; ++ii) { const float a = As[(16 * q + ii) * 65 + e_], u = Us[(16 * q + ii) * 65 + e_]; Ua = a * Ua + u; Ap *= a; }
    } else {
#pragma unroll
      for (int ii = 15; ii >= 0; --ii) { const float a = As[(16 * q + ii) * 65 + e_], u = Us[(16 * q + ii) * 65 + e_]; Ua = a * Ua + u; Ap *= a; }
    }
    segA[q * 64 + e_] = Ap; segU[q * 64 + e_] = Ua;
    __syncthreads();
    if (PASS == 0) {
      if (q == 0) {
        float A = 1.f, U = 0.f;
        if (dir == 0) { for (int s = 0; s < 4; ++s) { const float a = segA[s * 64 + e_], u = segU[s * 64 + e_]; U = a * U + u; A *= a; } }
        else { for (int s = 3; s >= 0; --s) { const float a = segA[s * 64 + e_], u = segU[s * 64 + e_]; U = a * U + u; A *= a; } }
        AGG[((size_t)(cgk * 2 + dir) * 2 + 0) * 1024 + ch] = A;
        AGG[((size_t)(cgk * 2 + dir) * 2 + 1) * 1024 + ch] = U;
      }
    } else {
      float hc = dir == 0 ? cin0 : cin1;
      if (dir == 0) {
        for (int s = 0; s < q; ++s) hc = segA[s * 64 + e_] * hc + segU[s * 64 + e_];
#pragma unroll
        for (int ii = 0; ii < 16; ++ii) { hc = As[(16 * q + ii) * 65 + e_] * hc + Us[(16 * q + ii) * 65 + e_]; hsum[ii] += hc; }
      } else {
        for (int s = 3; s > q; --s) hc = segA[s * 64 + e_] * hc + segU[s * 64 + e_];
#pragma unroll
        for (int ii = 15; ii >= 0; --ii) { hc = As[(16 * q + ii) * 65 + e_] * hc + Us[(16 * q + ii) * 65 + e_]; hsum[ii] += hc; }
      }
    }
  }
  if (PASS == 1) {
#pragma unroll
    for (int ii = 0; ii < 16; ++ii) {
      const int t = t0 + 16 * q + ii;
      const float gy = bf2f(PJ2[(size_t)t * 2048 + ch]);
      MIX[(size_t)t * 1024 + ch] = f2bf(gy * hsum[ii]);
    }
  }
}

__device__ __forceinline__ void rg_carry(const P& p, int jl, char* lds) {
  const float* AGG = (const float*)(p.ws + WS_RGAGG);
  float* CARRY = (float*)(p.ws + WS_CARRY);
  float* agA = (float*)lds; float* agU = agA + 256;
  const int tid = TID();
  for (int it = BID(); it < 256; it += gridDim.x) {
    const int cgp = it & 31, dir = (it >> 5) & 1, sq = it >> 6;
    const int cl = tid & 31, g = tid >> 5;
    const int ch = cgp * 32 + cl;
    const int chunk0 = 128 + sq * 64;
    float A[8], U[8]; int cc[8];
#pragma unroll
    for (int j = 0; j < 8; ++j) {
      const int k = g * 8 + j;
      cc[j] = dir == 0 ? chunk0 + k : chunk0 + 63 - k;
      A[j] = AGG[((size_t)(cc[j] * 2 + dir) * 2 + 0) * 1024 + ch];
      U[j] = AGG[((size_t)(cc[j] * 2 + dir) * 2 + 1) * 1024 + ch];
    }
    float a = 1.f, u = 0.f;
#pragma unroll
    for (int j = 0; j < 8; ++j) { u = A[j] * u + U[j]; a *= A[j]; }
    __syncthreads();
    agA[g * 32 + cl] = a; agU[g * 32 + cl] = u;
    __syncthreads();
    float h = p.in[5][((sq * 2 + jl) * 2 + dir) * 1024 + ch];
    for (int gg = 0; gg < g; ++gg) h = agA[gg * 32 + cl] * h + agU[gg * 32 + cl];
#pragma unroll
    for (int j = 0; j < 8; ++j) { CARRY[(size_t)(cc[j] * 2 + dir) * 1024 + ch] = h; h = A[j] * h + U[j]; }
  }
  for (int idx = BID() * 256 + tid; idx < 32 * 2048; idx += gridDim.x * 256) {
    const int ch = idx & 1023, dir = (idx >> 10) & 1, sq = idx >> 11;
    const int chunk0 = sq * 4;
    float h = 0.f;
    float A[4], U[4]; int cc[4];
#pragma unroll
    for (int k = 0; k < 4; ++k) {
      cc[k] = dir == 0 ? chunk0 + k : chunk0 + 3 - k;
      A[k] = AGG[((size_t)(cc[k] * 2 + dir) * 2 + 0) * 1024 + ch];
      U[k] = AGG[((size_t)(cc[k] * 2 + dir) * 2 + 1) * 1024 + ch];
    }
#pragma unroll
    for (int k = 0; k < 4; ++k) { CARRY[(size_t)(cc[k] * 2 + dir) * 1024 + ch] = h; h = A[k] * h + U[k]; }
    p.out[OUT_RG + ((sq * 2 + jl) * 2 + dir) * 1024 + ch] = h;
  }
}

#define XB_TMO      128
#define XB_XCNT(j)  (256  + 64 * (j))
#define XB_XSUB(j)  (1280 + 64 * (j))
#define XB_XGEN(j)  (2304 + 64 * (j))
#define XB_TOP      3328
#define XB_TOPGEN   3392
#define XCD_BAR_WORDS 3456
#define XB_SPIN_CAP (1u << 22)
__device__ __forceinline__ unsigned xb_ld(unsigned* p)              { return __hip_atomic_load(p, __ATOMIC_RELAXED, __HIP_MEMORY_SCOPE_AGENT); }
__device__ __forceinline__ unsigned xb_add(unsigned* p, unsigned v) { return __hip_atomic_fetch_add(p, v, __ATOMIC_RELAXED, __HIP_MEMORY_SCOPE_AGENT); }
__device__ __forceinline__ unsigned xb_xcc_id() { return (unsigned)__builtin_amdgcn_s_getreg((3 << 11) | 20) & 0xFu; }
#define XB_SPIN(cond, bar) do { unsigned _sp = 0; while (cond) { __builtin_amdgcn_s_sleep(1); \
    if ((++_sp & 255u) == 0u) { if (xb_ld(&(bar)[XB_TMO])) break; if (_sp > XB_SPIN_CAP) { atomicAdd(&(bar)[XB_TMO], 1u); break; } } } } while (0)
struct XcdBarrier { unsigned* bar; unsigned x; volatile unsigned* st; };
__device__ __forceinline__ XcdBarrier xcd_barrier_post(unsigned* bar, volatile unsigned* st) {
  XcdBarrier b; b.bar = bar; b.x = xb_xcc_id(); b.st = st;
  if (threadIdx.x == 0) (void)xb_add(&bar[XB_XCNT(b.x)], 1u);
  return b;
}
__device__ __forceinline__ void xcd_barrier_complete(unsigned* bar, unsigned x, unsigned& nloc, unsigned& nx) {
  const unsigned G = gridDim.x * gridDim.y * gridDim.z;
  unsigned sum, cnt, mine, sp = 0u;
  for (;;) {
    sum = 0u; cnt = 0u; mine = 0u;
#pragma unroll
    for (unsigned j = 0; j < 16; ++j) { const unsigned c = xb_ld(&bar[XB_XCNT(j)]); sum += c; cnt += (c > 0u) ? 1u : 0u; mine = (j == x) ? c : mine; }
    if (sum == G) break;
    __builtin_amdgcn_s_sleep(1);
    if ((++sp & 255u) == 0u) { if (xb_ld(&bar[XB_TMO])) break; if (sp > XB_SPIN_CAP) { atomicAdd(&bar[XB_TMO], 1u); break; } }
  }
  nloc = mine > 0u ? mine : 1u; nx = cnt > 0u ? cnt : 1u;
}
__device__ __forceinline__ void xcd_barrier(const XcdBarrier& b) {
  asm volatile("s_waitcnt vmcnt(0)" ::: "memory");
  __syncthreads();
  if (threadIdx.x == 0) {
    unsigned* bar = b.bar;
    __builtin_amdgcn_s_waitcnt(0);
    unsigned nloc = b.st[0], nx = b.st[1];
    if (nloc == 0u) { xcd_barrier_complete(bar, b.x, nloc, nx); b.st[0] = nloc; b.st[1] = nx; }
    const unsigned old = xb_add(&bar[XB_XSUB(b.x)], 1u);
    const unsigned gen = old / nloc;
    if (old + 1u == (gen + 1u) * nloc) {
      __builtin_amdgcn_fence(__ATOMIC_RELEASE, "agent");
      asm volatile("s_waitcnt vmcnt(0)" ::: "memory");
      const unsigned og = xb_add(&bar[XB_TOP], 1u);
      const unsigned tg = og / nx;
      if (og + 1u == (tg + 1u) * nx) xb_add(&bar[XB_TOPGEN], 1u);
      else XB_SPIN(xb_ld(&bar[XB_TOPGEN]) == tg, bar);
      __builtin_amdgcn_fence(__ATOMIC_ACQUIRE, "agent");
      xb_add(&bar[XB_XGEN(b.x)], 1u);
      asm volatile("s_waitcnt vmcnt(0)" ::: "memory");
    } else {
      XB_SPIN(xb_ld(&bar[XB_XGEN(b.x)]) == gen, bar);
      __builtin_amdgcn_fence(__ATOMIC_ACQUIRE, "agent");
      asm volatile("s_waitcnt vmcnt(0)" ::: "memory");
    }
  }
  __syncthreads();
}

__device__ __forceinline__ void run_phase(const P& p, int ph, char* lds) {
  if (ph == 0) { if (EN(0)) phase0(p, lds); if (PB(6)) phase0(p, lds); return; }
  if (ph == NPH - 1) { if (EN(13)) final_norm(p); return; }
  int q = ph - 1, layer = 0;
  for (; layer < 4; ++layer) { if (q < 10) break; q -= 10; }
  const bool even = (layer & 1) == 0;
  const int jl = layer >> 1;
  const int nmix = 6;
  const float* mod_l = (const float*)(p.ws + WS_MOD) + layer * 5 * 6144;
  bf16_t* WB = (bf16_t*)(p.ws + WS_WB);
  bf16_t* H = (bf16_t*)(p.ws + WS_H);
  bf16_t* REG = (bf16_t*)(p.ws + WS_REGION);
  GemmArgs g;
  g.m_off = 0; g.o16 = REG; g.X = p.out; g.gate = mod_l; g.outk = p.out + OUT_K; g.outv = p.out + OUT_V; g.jl = jl; g.dry = 0; g.cw = nullptr; g.cb = nullptr; g.halo = nullptr; g.x0p = nullptr; g.x0s = nullptr; g.qctr = (unsigned*)(p.ws + WS_QCTR) + ph * 128;
  if (q == 0) {
    if (EN(1)) convert_weights(p, layer, lds);
    if (EN(1)) norm_rows(p, p.in[8] + layer * 1024, mod_l, 0, layer == 0);
    if (PB(6)) { convert_weights(p, layer, lds); norm_rows(p, p.in[8] + layer * 1024, mod_l, 0, layer == 0); }
    if (!even) {
      float* RGC = (float*)(p.ws + WS_RGC);
      for (int idx = BID() * 256 + TID(); idx < 2048; idx += gridDim.x * 256) RGC[idx] = 8.f * logsigf_(p.in[27][jl * 2048 + idx]);
    }
    return;
  }
  if (q == 1) {
    g.A = H; g.lda = 1024; g.Bt = WB + WB_IN; g.K = 1024; g.M = T_ALL;
    if (even) { g.NP = EV_INP; if (EN(2)) gemm_phase<0>(g, lds); } else { g.NP = 2048; if (EN(3)) gemm_phase<1>(g, lds); }
#if PROBE_GEMM2
    if (even) { gemm_phase<0>(g, lds); } else { gemm_phase<1>(g, lds); }
#endif
    return;
  }
  if (q == nmix - 1) {
    g.A = H; g.lda = 1024; g.Bt = WB + WB_OUT; g.K = 1024; g.M = T_ALL; g.NP = 1024; g.gate = mod_l + 2 * 1024;
    if (layer == 0) { g.x0p = p.in[0]; g.x0s = p.in[1]; }
    if (EN(4)) gemm_phase<2>(g, lds);
#if PROBE_GEMM2
    g.dry = p.pad + 1; gemm_phase<2>(g, lds);
#endif
    return;
  }
  if (q < nmix) {
    if (even) {
      if (q == 2) {
        for (int it = BID(); it < 1536; it += gridDim.x) { if (EN(6)) gla_pass1_item(p, it, jl, lds); if (PB(2)) gla_pass1_item(p, it, jl, lds); }
      } else if (q == 3) {
        attn_stage_rope(p, lds);
        for (int it = BID(); it < 2304 + 1536; it += gridDim.x) {
          if (it < 2304) { if (EN(7)) gla_pass2_item(p, it, jl); if (PB(8)) gla_pass2_item(p, it, jl, p.pad + 1); }
          else { if (EN(5)) attn_item(p, it - 2304, jl, lds); if (PB(1)) attn_item(p, it - 2304, jl, lds); }
        }
      } else {
        for (int it = BID(); it < 1536; it += gridDim.x) { if (EN(8)) gla_pass3_item(p, it, jl, lds); if (PB(3)) gla_pass3_item(p, it, jl, lds); }
      }
    } else {
      if (q == 2) { for (int it = BID(); it < 6144; it += gridDim.x) { if (EN(9)) rg_item<0>(p, it, jl, lds); if (PB(4)) rg_item<0>(p, it, jl, lds); } }
      else if (q == 3) { rg_carry(p, jl, lds); }
      else { for (int it = BID(); it < 6144; it += gridDim.x) { if (EN(10)) rg_item<1>(p, it, jl, lds); if (PB(4)) rg_item<1>(p, it, jl, lds); } }
    }
    return;
  }
  const int f = q - nmix;
  if (f == 0) { if (EN(1)) norm_rows(p, p.in[9] + layer * 1024, mod_l, 3, false); return; }
  if (f == 1) {
    g.A = H; g.lda = 1024; g.Bt = WB + WB_UP; g.K = 1024; g.M = T_ALL; g.NP = DFF2;
    g.cw = p.in[30] + (size_t)layer * 3 * DFF2; g.cb = p.in[31] + (size_t)layer * DFF2; g.halo = (float*)(p.ws + WS_STATES);
    if (EN(12)) gemm_phase<3>(g, lds);
#if PROBE_GEMM2
    gemm_phase<3>(g, lds);
#endif
  } else if (f == 2) {
    if (EN(11)) ffn_fixup(p, layer);
    if (PB(10)) ffn_fixup(p, layer);
  } else {
    g.A = REG; g.lda = DFF; g.Bt = WB + WB_DOWN; g.K = DFF; g.M = T_ALL; g.NP = 1024;
    g.m_off = 0; g.gate = mod_l + 5 * 1024;
    if (EN(4)) gemm_phase<2>(g, lds);
#if PROBE_GEMM2
    g.dry = p.pad + 1; gemm_phase<2>(g, lds);
#endif
  }
}

__global__ void __launch_bounds__(256, 2) mega(P p) {
  extern __shared__ __attribute__((aligned(16))) char lds_raw[];
  char* lds = lds_raw + 16;
  XcdBarrier xb;
  if (p.coop) {
    volatile unsigned* st = (volatile unsigned*)lds_raw;
    if (threadIdx.x == 0) { st[0] = 0u; st[1] = 0u; st[2] = 0u; st[3] = 0u; }
    __syncthreads();
    xb = xcd_barrier_post((unsigned*)(p.ws + WS_BAR), st);
  }
  for (int ph = p.ph_lo; ph < p.ph_hi; ++ph) {
    run_phase(p, ph, lds);
    if (p.coop && ph + 1 < p.ph_hi) {
      if (ph == p.ph_lo) cg::this_grid().sync();
      else { xcd_barrier(xb); if (PB(7)) xcd_barrier(xb); }
    }
  }
}

extern "C" void kernel_launch(void* const* d_in, const int* in_sizes, int n_in, void* d_out, int out_size, void* d_ws, size_t ws_size,
                              hipStream_t stream) {
  static int grid = 0;
  if (!grid) {
    int dev = 0, cus = 0, per_cu = 0;
    (void)hipGetDevice(&dev);
    (void)hipDeviceGetAttribute(&cus, hipDeviceAttributeMultiprocessorCount, dev);
    (void)hipFuncSetAttribute((const void*)mega, hipFuncAttributeMaxDynamicSharedMemorySize, LDS_BYTES);
    (void)hipOccupancyMaxActiveBlocksPerMultiprocessor(&per_cu, (const void*)mega, 256, LDS_BYTES);
    if (per_cu < 1) per_cu = 1;
    if (per_cu > 2) per_cu = 2;
    grid = cus * per_cu;
    if (ws_size < WS_END) fprintf(stderr, "kernel_launch: workspace too small: %zu < %llu\n", ws_size, (unsigned long long)WS_END);
  }
  P p;
  memset(&p, 0, sizeof(p));
  for (int i = 0; i < 34; ++i) p.in[i] = (const float*)d_in[i];
  p.out = (float*)d_out; p.ws = (unsigned char*)d_ws;
#if COOP
  (void)hipMemsetAsync((char*)d_ws + WS_BAR, 0, 16384 + 32768, stream);
  p.ph_lo = 0; p.ph_hi = NPH; p.coop = 1;
  void* args[] = {&p};
  hipError_t e = hipLaunchCooperativeKernel((const void*)mega, dim3(grid), dim3(256), args, LDS_BYTES, stream);
  if (e != hipSuccess) fprintf(stderr, "cooperative launch failed: %s (grid %d)\n", hipGetErrorString(e), grid);
#else
  for (int ph = 0; ph < NPH; ++ph) {
    p.ph_lo = ph; p.ph_hi = ph + 1; p.coop = 0;
    hipLaunchKernelGGL(mega, dim3(grid), dim3(256), LDS_BYTES, stream, p);
  }
#endif
}
```
